# Optimizing an MI355X kernel written in HIP

```python
import math
import jax, jax.numpy as jnp
from jax import lax
import numpy as np

D_MODEL = 1024
BATCH = 16
SEQ = 2048
DEPTH = 1

CHUNK = 64
Q_BLOCK = 128
N_MEM = 256
EPS = 1e-6

DA_HEADS = 4
DA_QK_DIM = 64
DA_V_DIM = 2 * DA_QK_DIM
DA_WIDTH = DA_HEADS * DA_V_DIM
FX_HEADS = 8
FX_DIM = 64
FX_WIDTH = FX_HEADS * FX_DIM
MEM_HEADS = 4
MEM_DIM = 128
MEM_WIDTH = MEM_HEADS * MEM_DIM
N_BRANCH = 3
D_FF = 2816
CONV_W = 3

IN_SIZES = (DA_HEADS * 2 * DA_QK_DIM, DA_HEADS * 2 * DA_QK_DIM, DA_WIDTH,
            FX_WIDTH, FX_WIDTH, FX_WIDTH, FX_HEADS,
            MEM_WIDTH,
            N_BRANCH * D_MODEL)
IN_COLS = sum(IN_SIZES)

kernel_name = "hybrid_diffattn_fox_memxattn_convffn"


def rms_norm(x, g):
    xf = x.astype(jnp.float32)
    y = xf * lax.rsqrt(jnp.mean(xf * xf, axis=-1, keepdims=True) + EPS)
    return (y * g.astype(jnp.float32)).astype(x.dtype)


def lambda_init(layer_idx):
    return 0.8 - 0.6 * math.exp(-0.3 * layer_idx)


def alibi_slopes(n):
    return jnp.array([2.0 ** (-8.0 * (i + 1) / n) for i in range(n)], dtype=jnp.float32)


def split_heads(t, n_heads, d):
    b, s, _ = t.shape
    return t.reshape(b, s, n_heads, d).transpose(0, 2, 1, 3)


def merge_heads(t):
    b, h, s, d = t.shape
    return t.transpose(0, 2, 1, 3).reshape(b, s, h * d)


def diff_attention(q, k, v, lam, slopes):
    s_len = q.shape[3]
    scale = DA_QK_DIM ** -0.5
    pos = jnp.arange(s_len)
    outs = []
    for i in range(s_len // Q_BLOCK):
        q0, q1 = i * Q_BLOCK, (i + 1) * Q_BLOCK
        tq, tk = pos[q0:q1], pos[:q1]
        s = jnp.einsum('bhcqd,bhckd->bhcqk', q[:, :, :, q0:q1], k[:, :, :, :q1]).astype(jnp.float32) * scale
        dist = jnp.abs(tq[:, None] - tk[None, :]).astype(jnp.float32)
        bias = -slopes[:, None, None] * dist
        mask = (tk[None, :] // CHUNK) <= (tq[:, None] // CHUNK)
        s = jnp.where(mask, s + bias[None, :, None], -jnp.inf)
        p = jax.nn.softmax(s, axis=-1)
        w = p[:, :, 0] - lam * p[:, :, 1]
        outs.append(jnp.einsum('bhqk,bhkd->bhqd', w.astype(v.dtype), v[:, :, :q1]))
    return jnp.concatenate(outs, axis=2)


def forgetting_attention(q, k, v, log_f):
    s_len = q.shape[2]
    scale = FX_DIM ** -0.5
    c = jnp.cumsum(log_f, axis=-1)
    pos = jnp.arange(s_len)
    outs = []
    for i in range(s_len // Q_BLOCK):
        q0, q1 = i * Q_BLOCK, (i + 1) * Q_BLOCK
        tq, tk = pos[q0:q1], pos[:q1]
        s = jnp.einsum('bhqd,bhkd->bhqk', q[:, :, q0:q1], k[:, :, :q1]).astype(jnp.float32) * scale
        s = s + c[:, :, q0:q1, None] - c[:, :, None, :q1]
        s = jnp.where(tk[None, :] <= tq[:, None], s, -jnp.inf)
        p = jax.nn.softmax(s, axis=-1)
        outs.append(jnp.einsum('bhqk,bhkd->bhqd', p.astype(v.dtype), v[:, :, :q1]))
    return jnp.concatenate(outs, axis=2)


def memory_attention(q, k, v):
    s = jnp.einsum('bhqd,bhkd->bhqk', q, k).astype(jnp.float32) * (MEM_DIM ** -0.5)
    p = jax.nn.softmax(s, axis=-1)
    return jnp.einsum('bhqk,bhkd->bhqd', p.astype(v.dtype), v)


def setup_inputs(seed: int = 0) -> dict:
    key = jax.random.key(seed)
    ks = jax.random.split(key, 32)
    f32 = jnp.float32

    def nrm(k, shape, scale):
        return jax.random.normal(k, shape, f32) * scale

    def gain(k, shape):
        return 1.0 + 0.05 * jax.random.normal(k, shape, f32)

    L = DEPTH
    return {
        "x": nrm(ks[0], (BATCH, SEQ, D_MODEL), 1.0),
        "mem": nrm(ks[1], (BATCH, N_MEM, D_MODEL), 1.0),
        "norm_mix": gain(ks[2], (L, D_MODEL)),
        "w_in": nrm(ks[3], (L, D_MODEL, IN_COLS), D_MODEL ** -0.5),
        "b_gate": nrm(ks[4], (L, N_BRANCH, D_MODEL), 0.1),
        "da_q_norm": gain(ks[5], (L, DA_QK_DIM)),
        "da_k_norm": gain(ks[6], (L, DA_QK_DIM)),
        "da_lambda_q1": nrm(ks[7], (L, DA_QK_DIM), 0.1),
        "da_lambda_k1": nrm(ks[8], (L, DA_QK_DIM), 0.1),
        "da_lambda_q2": nrm(ks[9], (L, DA_QK_DIM), 0.1),
        "da_lambda_k2": nrm(ks[10], (L, DA_QK_DIM), 0.1),
        "da_subln": gain(ks[11], (L, DA_V_DIM)),
        "fx_q_norm": gain(ks[12], (L, FX_DIM)),
        "fx_k_norm": gain(ks[13], (L, FX_DIM)),
        "fx_f_bias": 3.0 + 0.5 * jax.random.normal(ks[14], (L, FX_HEADS), f32),
        "mem_norm": gain(ks[15], (L, D_MODEL)),
        "w_mem_kv": nrm(ks[16], (L, D_MODEL, 2 * MEM_WIDTH), D_MODEL ** -0.5),
        "mem_q_norm": gain(ks[17], (L, MEM_DIM)),
        "mem_k_norm": gain(ks[18], (L, MEM_DIM)),
        "w_branch_da": nrm(ks[19], (L, DA_WIDTH, D_MODEL), DA_WIDTH ** -0.5),
        "w_branch_fx": nrm(ks[20], (L, FX_WIDTH, D_MODEL), FX_WIDTH ** -0.5),
        "w_branch_mem": nrm(ks[21], (L, MEM_WIDTH, D_MODEL), MEM_WIDTH ** -0.5),
        "w_out": nrm(ks[22], (L, D_MODEL, D_MODEL), D_MODEL ** -0.5),
        "norm_ffn": gain(ks[23], (L, D_MODEL)),
        "w_up": nrm(ks[24], (L, D_MODEL, 2 * D_FF), D_MODEL ** -0.5),
        "conv_w": nrm(ks[25], (L, CONV_W, 2 * D_FF), CONV_W ** -0.5),
        "conv_b": nrm(ks[26], (L, 2 * D_FF), 0.02),
        "w_down": nrm(ks[27], (L, D_FF, D_MODEL), D_FF ** -0.5),
    }


def reference(x, mem, norm_mix, w_in, b_gate, da_q_norm, da_k_norm,
              da_lambda_q1, da_lambda_k1, da_lambda_q2, da_lambda_k2, da_subln,
              fx_q_norm, fx_k_norm, fx_f_bias, mem_norm, w_mem_kv, mem_q_norm, mem_k_norm,
              w_branch_da, w_branch_fx, w_branch_mem, w_out,
              norm_ffn, w_up, conv_w, conv_b, w_down):
    b, s_len, _ = x.shape
    offsets = np.cumsum(np.array(IN_SIZES))[:-1].tolist()
    slopes = alibi_slopes(DA_HEADS)
    for l in range(DEPTH):
        h = rms_norm(x, norm_mix[l])
        proj = h @ w_in[l]
        (a_q, a_k, a_v, f_q, f_k, f_v, f_gate, m_q, g_logit) = jnp.split(proj, offsets, axis=-1)

        lam_init = lambda_init(l)
        qa = a_q.reshape(b, s_len, DA_HEADS, 2, DA_QK_DIM).transpose(0, 2, 3, 1, 4)
        ka = a_k.reshape(b, s_len, DA_HEADS, 2, DA_QK_DIM).transpose(0, 2, 3, 1, 4)
        qa = rms_norm(qa, da_q_norm[l])
        ka = rms_norm(ka, da_k_norm[l])
        va = split_heads(a_v, DA_HEADS, DA_V_DIM)
        lam = (jnp.exp(jnp.sum(da_lambda_q1[l].astype(jnp.float32) * da_lambda_k1[l].astype(jnp.float32)))
               - jnp.exp(jnp.sum(da_lambda_q2[l].astype(jnp.float32) * da_lambda_k2[l].astype(jnp.float32)))
               + lam_init)
        oa = diff_attention(qa, ka, va, lam, slopes)
        oa = rms_norm(oa, da_subln[l]) * (1.0 - lam_init)
        ya = merge_heads(oa) @ w_branch_da[l]

        qf = rms_norm(split_heads(f_q, FX_HEADS, FX_DIM), fx_q_norm[l])
        kf = rms_norm(split_heads(f_k, FX_HEADS, FX_DIM), fx_k_norm[l])
        vf = split_heads(f_v, FX_HEADS, FX_DIM)
        log_f = jax.nn.log_sigmoid((f_gate + fx_f_bias[l]).astype(jnp.float32)).transpose(0, 2, 1)
        of = forgetting_attention(qf, kf, vf, log_f)
        yf = merge_heads(of) @ w_branch_fx[l]

        mh = rms_norm(mem, mem_norm[l])
        m_k, m_v = jnp.split(mh @ w_mem_kv[l], 2, axis=-1)
        qm = rms_norm(split_heads(m_q, MEM_HEADS, MEM_DIM), mem_q_norm[l])
        km = rms_norm(split_heads(m_k, MEM_HEADS, MEM_DIM), mem_k_norm[l])
        vm = split_heads(m_v, MEM_HEADS, MEM_DIM)
        om = memory_attention(qm, km, vm)
        ym = merge_heads(om) @ w_branch_mem[l]

        gates = jax.nn.sigmoid(g_logit.reshape(b, s_len, N_BRANCH, D_MODEL) + b_gate[l])
        merged = gates[:, :, 0] * ya + gates[:, :, 1] * yf + gates[:, :, 2] * ym
        x = x + merged @ w_out[l]

        h2 = rms_norm(x, norm_ffn[l])
        u = h2 @ w_up[l]
        u_pad = jnp.pad(u, ((0, 0), (CONV_W - 1, 0), (0, 0)))
        cw = conv_w[l]
        uc = sum(u_pad[:, j:j + s_len] * cw[j] for j in range(CONV_W)) + conv_b[l]
        a, g = jnp.split(uc, 2, axis=-1)
        x = x + (jax.nn.silu(a) * g) @ w_down[l]
    return x
```

```cpp
#include <hip/hip_runtime.h>
#include <hip/hip_cooperative_groups.h>
#include <cstdio>
#include <cstdint>
namespace cg = cooperative_groups;

#ifndef MK_PER_PHASE
#define MK_PER_PHASE 0
#endif

#define LAS __attribute__((address_space(3)))
typedef unsigned short bf16_t;
typedef short bf16x8 __attribute__((ext_vector_type(8)));
typedef short s16x4 __attribute__((ext_vector_type(4)));
typedef float f32x4 __attribute__((ext_vector_type(4)));
typedef float f32x16 __attribute__((ext_vector_type(16)));
typedef float f32x2 __attribute__((ext_vector_type(2)));
typedef unsigned u32x4 __attribute__((ext_vector_type(4)));
typedef unsigned u32x2 __attribute__((ext_vector_type(2)));
typedef __bf16 bf16x2_t __attribute__((ext_vector_type(2)));

constexpr int DM = 1024, NB = 16, SEQ = 2048, NTOK = NB * SEQ, NMEM = 256, NMTOK = NB * NMEM;
constexpr int INCOLS = 6664, DFF = 2816, UPN = 5632;
constexpr float EPS = 1e-6f, LOG2E = 1.4426950408889634f;
constexpr int QKP = 2560, GP = 3072;
constexpr int NWAVES = 8;
constexpr int LDS_BYTES = 147456;

constexpr size_t MiB = 1u << 20;
constexpr size_t WS_CTL = 0, WS_LOGF = 1 * MiB, WS_C2 = 2 * MiB, WS_SS = 3 * MiB, WS_MK = 4 * MiB, WS_MVT = 8 * MiB;
constexpr size_t WS_W1 = 12 * MiB, WS_WV = 23 * MiB, WS_WMK = 25 * MiB, WS_WMV = 26 * MiB, WS_WBR = 27 * MiB, WS_WOUT = 30 * MiB;
constexpr size_t WS_WUP = 32 * MiB, WS_WDN = 43 * MiB, WS_MH = 56 * MiB;
constexpr size_t WS_QK = 64 * MiB, WS_G = 224 * MiB, WS_O = 416 * MiB;
constexpr size_t WS_MERGED = 64 * MiB, WS_X1B = 128 * MiB, WS_ACT = 224 * MiB, WS_UB = 400 * MiB;

__device__ __forceinline__ unsigned cvtpk(float lo, float hi) { f32x2 v = {lo, hi}; bf16x2_t b = __builtin_convertvector(v, bf16x2_t); return __builtin_bit_cast(unsigned, b); }
__device__ __forceinline__ float bf2f(unsigned short b) { return __uint_as_float((unsigned)b << 16); }
__device__ __forceinline__ float bflo(unsigned w) { return __uint_as_float(w << 16); }
__device__ __forceinline__ float bfhi(unsigned w) { return __uint_as_float(w & 0xffff0000u); }
__device__ __forceinline__ float dpp_shr1(float v) { return __int_as_float(__builtin_amdgcn_update_dpp(0, __float_as_int(v), 0x111  , 0xf, 0xf, false)); }
__device__ __forceinline__ float wave_sum(float v) {
    v += __int_as_float(__builtin_amdgcn_update_dpp(0, __float_as_int(v), 0xB1, 0xf, 0xf, false));
    v += __int_as_float(__builtin_amdgcn_update_dpp(0, __float_as_int(v), 0x4E, 0xf, 0xf, false));
    v += __int_as_float(__builtin_amdgcn_update_dpp(0, __float_as_int(v), 0x141, 0xf, 0xf, false));
    v += __int_as_float(__builtin_amdgcn_update_dpp(0, __float_as_int(v), 0x140, 0xf, 0xf, false));
    v += __int_as_float(__builtin_amdgcn_update_dpp(0, __float_as_int(v), 0x142, 0xa, 0xf, false));
    v += __int_as_float(__builtin_amdgcn_update_dpp(0, __float_as_int(v), 0x143, 0xc, 0xf, false));
    return __int_as_float(__builtin_amdgcn_readlane(__float_as_int(v), 63));
}
__device__ __forceinline__ float sum_fq(float v) {
    { const auto r = __builtin_amdgcn_permlane16_swap(__float_as_uint(v), __float_as_uint(v), false, false); v = __uint_as_float(r[0]) + __uint_as_float(r[1]); }
    { const auto r = __builtin_amdgcn_permlane32_swap(__float_as_uint(v), __float_as_uint(v), false, false); v = __uint_as_float(r[0]) + __uint_as_float(r[1]); }
    return v;
}
__device__ __forceinline__ float fast_exp2(float x) { return __builtin_amdgcn_exp2f(x); }
__device__ __forceinline__ float fast_rcp(float x) { return __builtin_amdgcn_rcpf(x); }
__device__ __forceinline__ float sigmoidf_(float z) { return fast_rcp(1.f + fast_exp2(-z * LOG2E)); }

namespace pg8 {
constexpr int BM = 256, BK = 64, HALF = 128, HTB = HALF * BK * 2, STAGE_BYTES = 8 * HTB, NXCD = 8, WGM = 8;
__host__ __device__ __forceinline__ int lds_byte(int r, int c) { const int st = (r >> 4) * 2 + (c >> 5), rr = r & 15, cc = c & 31, ob = rr * 64 + cc * 2; return st * 1024 + (ob ^ (((ob >> 9) & 1) << 5)); }
__host__ __device__ __forceinline__ void stage_rc(int b, int& R, int& C) { const int st = b / 1024, sb = b % 1024, swz = sb ^ (((sb >> 9) & 1) << 5); R = (st >> 1) * 16 + swz / 64; C = (st & 1) * 32 + (swz % 64) / 2; }

struct Unit { int pm, pn, seg; };
struct Gemm { const char* A; const char* Bt; int K; int a_perm; size_t a_seg, b_seg; };

struct Order {
    int nM, nN, nwg, G, c, nseg;
    __device__ void init(int M, int N, int G_, int c_, int nseg_) { nM = M / BM; nN = N / BM; nwg = nM * nN; G = G_; c = c_; nseg = nseg_; }
    __device__ bool next(int i, Unit& u) const {
        const int seg = i % nseg, ii = i / nseg;
        const long L = (long)ii * G + c; if (L >= nwg) return false;
        int wgid = (int)L; { const int q = nwg / NXCD, r = nwg % NXCD, xcd = wgid % NXCD, off = wgid / NXCD; wgid = (xcd < r ? xcd * (q + 1) : r * (q + 1) + (xcd - r) * q) + off; }
        const int nig = WGM * nN, gid = wgid / nig, fm = gid * WGM, gsz = (nM - fm) < WGM ? (nM - fm) : WGM;
        u.pm = fm + ((wgid % nig) % gsz); u.pn = (wgid % nig) / gsz; u.seg = seg; return true;
    }
};

template <class Epi>
__device__ __forceinline__ void gemm_phase(LAS unsigned char* lds, const Gemm g, const Order& S, const Epi& E) {
    const int tid = threadIdx.x, wid = __builtin_amdgcn_readfirstlane(tid >> 6), lane = tid & 63, wr = wid >> 2, wc = wid & 3, fr = lane & 15, fq = lane >> 4;
    const int K = g.K, nt = K / BK;
    unsigned voffA[2], voffB[2];
#pragma unroll
    for (int i = 0; i < 2; ++i) { int R, C; stage_rc(tid * 16 + i * 8192, R, C);
        const int Ra = g.a_perm ? (8 * (16 * (R >> 6) + (R & 15)) + ((R >> 4) & 3)) : R;
        voffA[i] = (unsigned)(Ra * K + C) * 2u; voffB[i] = (unsigned)(R * K + C) * 2u; }
    const size_t kstep = (size_t)(BK * 2);
    const size_t hstep = (size_t)HALF * K * 2;
    const size_t hstepA = g.a_perm ? (size_t)4 * K * 2 : hstep;
    const size_t tstep = 2 * hstep;
    const unsigned ldsw = (unsigned)wid * 1024u;
    const int aoff = lds_byte(wr * 64 + fr, fq * 8), boff = lds_byte(wc * 32 + fr, fq * 8);
#define PG8_SA(b, h) (((b) * 2 + (h)) * HTB)
#define PG8_SB(b, h) ((4 + (b) * 2 + (h)) * HTB)
#define PG8_STAGE(bufoff, gbase, voff) do { _Pragma("unroll") for (int _i = 0; _i < 2; ++_i) \
        __builtin_amdgcn_global_load_lds((const unsigned*)((const char*)(gbase) + (voff)[_i]), (LAS unsigned*)(lds + (bufoff) + ldsw + _i * 8192), 16, 0, 0); } while (0)
#define PG8_LDA(dst, b, h) do { _Pragma("unroll") for (int m = 0; m < 4; ++m) _Pragma("unroll") for (int k = 0; k < 2; ++k) dst[m][k] = *(const LAS bf16x8*)(lds + PG8_SA(b, h) + aoff + m * 2048 + k * 1024); } while (0)
#define PG8_LDB(dst, b, h) do { _Pragma("unroll") for (int n = 0; n < 2; ++n) _Pragma("unroll") for (int k = 0; k < 2; ++k) dst[n][k] = *(const LAS bf16x8*)(lds + PG8_SB(b, h) + boff + n * 2048 + k * 1024); } while (0)
#define PG8_MMA(ai, bj, At, Bt) do { __builtin_amdgcn_s_setprio(1); _Pragma("unroll") for (int m = 0; m < 4; ++m) _Pragma("unroll") for (int n = 0; n < 2; ++n) _Pragma("unroll") for (int k = 0; k < 2; ++k) \
        acc[ai][bj][m][n] = __builtin_amdgcn_mfma_f32_16x16x32_bf16(Bt[n][k], At[m][k], acc[ai][bj][m][n], 0, 0, 0); __builtin_amdgcn_s_setprio(0); } while (0)
#define PG8_WAIT_V(n) asm volatile("s_waitcnt vmcnt(" #n ")" ::: "memory")
#define PG8_WAIT_L(n) asm volatile("s_waitcnt lgkmcnt(" #n ")" ::: "memory")
#define PG8_BAR __builtin_amdgcn_s_barrier()
#define PG8_SCHED __builtin_amdgcn_sched_barrier(0)
    Unit cur, nxt; int ui = 0;
    if (!S.next(0, cur)) return;
    f32x4 acc[2][2][4][2];
#pragma unroll
    for (int a = 0; a < 2; ++a)
#pragma unroll
        for (int b = 0; b < 2; ++b)
#pragma unroll
            for (int m = 0; m < 4; ++m)
#pragma unroll
                for (int n = 0; n < 2; ++n) acc[a][b][m][n] = (f32x4){0.f, 0.f, 0.f, 0.f};
    bf16x8 At[4][2], B0[2][2], B1[2][2];
    const char* cA = g.A + (size_t)cur.pm * tstep + (size_t)cur.seg * g.a_seg; const char* cB = g.Bt + (size_t)cur.pn * tstep + (size_t)cur.seg * g.b_seg;
    PG8_STAGE(PG8_SB(0, 0), cB, voffB); PG8_STAGE(PG8_SB(0, 1), cB + hstep, voffB); PG8_STAGE(PG8_SA(0, 0), cA, voffA); PG8_STAGE(PG8_SA(0, 1), cA + hstepA, voffA);
    if (wr == 1) PG8_BAR;
    PG8_WAIT_V(2); PG8_BAR;
    PG8_STAGE(PG8_SB(1, 0), cB + kstep, voffB); PG8_STAGE(PG8_SA(1, 0), cA + kstep, voffA); PG8_STAGE(PG8_SB(1, 1), cB + hstep + kstep, voffB);
    PG8_WAIT_V(6); PG8_BAR;
    for (;;) {
        const bool has_next = S.next(ui + 1, nxt);
        const char* nA = has_next ? g.A + (size_t)nxt.pm * tstep + (size_t)nxt.seg * g.a_seg : cA; const char* nB = has_next ? g.Bt + (size_t)nxt.pn * tstep + (size_t)nxt.seg * g.b_seg : cB;
        for (int t = 0; t < nt; t += 2) {
            const bool last = (t == nt - 2);
            const char* a1 = cA + (size_t)(t + 1) * kstep;
            const char* a2 = last ? nA : cA + (size_t)(t + 2) * kstep; const char* b2 = last ? nB : cB + (size_t)(t + 2) * kstep;
            const char* a3 = a2 + kstep; const char* b3 = b2 + kstep;
            PG8_LDB(B0, 0, 0); PG8_LDB(B1, 0, 1); PG8_SCHED; PG8_LDA(At, 0, 0); PG8_STAGE(PG8_SA(1, 1), a1 + hstepA, voffA);
            PG8_WAIT_V(8); PG8_WAIT_L(0); PG8_BAR; PG8_MMA(0, 0, At, B0); PG8_MMA(0, 1, At, B1); PG8_BAR; PG8_SCHED;
            PG8_LDA(At, 0, 1); PG8_STAGE(PG8_SB(0, 0), b2, voffB); PG8_STAGE(PG8_SB(0, 1), b2 + hstep, voffB); PG8_STAGE(PG8_SA(0, 0), a2, voffA);
            PG8_WAIT_V(8); PG8_WAIT_L(0); PG8_BAR; PG8_MMA(1, 0, At, B0); PG8_MMA(1, 1, At, B1); PG8_BAR; PG8_SCHED;
            PG8_LDB(B0, 1, 0); PG8_LDB(B1, 1, 1); PG8_SCHED; PG8_LDA(At, 1, 0); PG8_STAGE(PG8_SA(0, 1), a2 + hstepA, voffA);
            PG8_WAIT_V(8); PG8_WAIT_L(0); PG8_BAR; PG8_MMA(0, 0, At, B0); PG8_MMA(0, 1, At, B1); PG8_BAR; PG8_SCHED;
            PG8_LDA(At, 1, 1); PG8_STAGE(PG8_SB(1, 0), b3, voffB); PG8_STAGE(PG8_SB(1, 1), b3 + hstep, voffB); PG8_STAGE(PG8_SA(1, 0), a3, voffA);
            PG8_WAIT_V(8); PG8_WAIT_L(0); PG8_BAR; PG8_MMA(1, 0, At, B0); PG8_MMA(1, 1, At, B1); PG8_BAR; PG8_SCHED;
        }
        if (wr == 0) PG8_BAR;
        E(acc, cur, wr, wc, fr, fq);
        if (!has_next) break;
        if (E.reset_after(cur))
#pragma unroll
        for (int a = 0; a < 2; ++a)
#pragma unroll
            for (int b = 0; b < 2; ++b)
#pragma unroll
                for (int m = 0; m < 4; ++m)
#pragma unroll
                    for (int n = 0; n < 2; ++n) acc[a][b][m][n] = (f32x4){0.f, 0.f, 0.f, 0.f};
        cur = nxt; cA = nA; cB = nB; ++ui;
        if (wr == 1) PG8_BAR;
    }
    PG8_WAIT_V(0);
    PG8_BAR;
#undef PG8_SA
#undef PG8_SB
#undef PG8_STAGE
#undef PG8_LDA
#undef PG8_LDB
#undef PG8_MMA
#undef PG8_WAIT_V
#undef PG8_WAIT_L
#undef PG8_BAR
#undef PG8_SCHED
}
}
using pg8::Unit;
typedef f32x4 Acc[2][2][4][2];

__device__ __forceinline__ int perm16(int c) { return ((c >> 5) & 3) * 64 + ((c >> 2) & 3) * 16 + (c >> 7) * 8 + ((c >> 4) & 1) * 4 + (c & 3); }

struct EpiProj {
    __device__ __forceinline__ bool reset_after(const Unit&) const { return true; }
    bf16_t* QK; unsigned char* G; const float* GN; const float* b_gate;
    __device__ __forceinline__ void operator()(const Acc& acc, const Unit& u, int wr, int wc, int fr, int fq) const {
        const int row0 = u.pm * 256 + wr * 64 + fr, lcol = wc * 64 + fq * 16;
        if (u.pn < 10) {
            const int kind = u.pn >> 1;
            bf16_t* base = QK + (size_t)row0 * QKP + u.pn * 256 + lcol;
            if (kind < 4) {
                const float* gp = GN + kind * 64 + fq * 16;
                const f32x4 gn0 = *(const f32x4*)(gp), gn1 = *(const f32x4*)(gp + 4), gn2 = *(const f32x4*)(gp + 8), gn3 = *(const f32x4*)(gp + 12);
#pragma unroll
                for (int ai = 0; ai < 2; ++ai)
#pragma unroll
                    for (int m = 0; m < 4; ++m) {
                        float ss = 0.f;
#pragma unroll
                        for (int bj = 0; bj < 2; ++bj)
#pragma unroll
                            for (int n = 0; n < 2; ++n) { const f32x4 v = acc[ai][bj][m][n]; ss += (v[0] * v[0] + v[1] * v[1]) + (v[2] * v[2] + v[3] * v[3]); }
                        ss = sum_fq(ss);
                        const float rs = rsqrtf(ss * (1.f / 64.f) + EPS);
                        bf16_t* rowp = base + (size_t)(ai * 128 + m * 16) * QKP;
#pragma unroll
                        for (int bj = 0; bj < 2; ++bj) {
                            const f32x4 v0 = acc[ai][bj][m][0] * rs * (bj ? gn2 : gn0), v1 = acc[ai][bj][m][1] * rs * (bj ? gn3 : gn1);
                            u32x4 w; w.x = cvtpk(v0[0], v0[1]); w.y = cvtpk(v0[2], v0[3]); w.z = cvtpk(v1[0], v1[1]); w.w = cvtpk(v1[2], v1[3]);
                            *(u32x4*)(rowp + 8 * bj) = w; }
                    }
            } else {
#pragma unroll
                for (int ai = 0; ai < 2; ++ai)
#pragma unroll
                    for (int m = 0; m < 4; ++m) {
                        bf16_t* rowp = base + (size_t)(ai * 128 + m * 16) * QKP;
#pragma unroll
                        for (int bj = 0; bj < 2; ++bj) {
                            const f32x4 v0 = acc[ai][bj][m][0], v1 = acc[ai][bj][m][1];
                            u32x4 w; w.x = cvtpk(v0[0], v0[1]); w.y = cvtpk(v0[2], v0[3]); w.z = cvtpk(v1[0], v1[1]); w.w = cvtpk(v1[2], v1[3]);
                            *(u32x4*)(rowp + 8 * bj) = w; }
                    }
            }
        } else {
            const int col = (u.pn - 10) * 256 + lcol;
            unsigned char* base = G + (size_t)row0 * GP + col;
            const f32x4 bv0 = *(const f32x4*)(b_gate + col), bv1 = *(const f32x4*)(b_gate + col + 4), bv2 = *(const f32x4*)(b_gate + col + 8), bv3 = *(const f32x4*)(b_gate + col + 12);
#pragma unroll
            for (int ai = 0; ai < 2; ++ai)
#pragma unroll
                for (int m = 0; m < 4; ++m) {
                    u32x4 w;
#pragma unroll
                    for (int bj = 0; bj < 2; ++bj)
#pragma unroll
                        for (int n = 0; n < 2; ++n) {
                            const f32x4 v = acc[ai][bj][m][n] + (bj ? (n ? bv3 : bv2) : (n ? bv1 : bv0));
                            const unsigned q0 = (unsigned)(sigmoidf_(v[0]) * 255.f + 0.5f), q1 = (unsigned)(sigmoidf_(v[1]) * 255.f + 0.5f), q2 = (unsigned)(sigmoidf_(v[2]) * 255.f + 0.5f), q3 = (unsigned)(sigmoidf_(v[3]) * 255.f + 0.5f);
                            w[2 * bj + n] = q0 | (q1 << 8) | (q2 << 16) | (q3 << 24);
                        }
                    *(u32x4*)(base + (size_t)(ai * 128 + m * 16) * GP) = w;
                }
        }
    }
};
struct EpiNat {
    __device__ __forceinline__ bool reset_after(const Unit&) const { return true; }
    bf16_t* O; int ldc;
    __device__ __forceinline__ void operator()(const Acc& acc, const Unit& u, int wr, int wc, int fr, int fq) const {
        bf16_t* base = O + (size_t)(u.pm * 256 + wr * 64 + fr) * ldc + u.pn * 256 + wc * 32 + fq * 4;
#pragma unroll
        for (int ai = 0; ai < 2; ++ai)
#pragma unroll
            for (int m = 0; m < 4; ++m) {
                bf16_t* rowp = base + (size_t)(ai * 128 + m * 16) * ldc;
#pragma unroll
                for (int bj = 0; bj < 2; ++bj)
#pragma unroll
                    for (int n = 0; n < 2; ++n) { const f32x4 v = acc[ai][bj][m][n]; u32x2 w; w.x = cvtpk(v[0], v[1]); w.y = cvtpk(v[2], v[3]); *(u32x2*)(rowp + bj * 128 + n * 16) = w; }
            }
    }
};
struct EpiPlain {
    __device__ __forceinline__ bool reset_after(const Unit&) const { return true; }
    bf16_t* O; int ldc;
    __device__ __forceinline__ void operator()(const Acc& acc, const Unit& u, int wr, int wc, int fr, int fq) const {
        bf16_t* base = O + (size_t)(u.pm * 256 + wr * 64 + fr) * ldc + u.pn * 256 + wc * 64 + fq * 16;
#pragma unroll
        for (int ai = 0; ai < 2; ++ai)
#pragma unroll
            for (int m = 0; m < 4; ++m) {
                bf16_t* rowp = base + (size_t)(ai * 128 + m * 16) * ldc;
#pragma unroll
                for (int bj = 0; bj < 2; ++bj) {
                    const f32x4 v0 = acc[ai][bj][m][0], v1 = acc[ai][bj][m][1];
                    u32x4 w; w.x = cvtpk(v0[0], v0[1]); w.y = cvtpk(v0[2], v0[3]); w.z = cvtpk(v1[0], v1[1]); w.w = cvtpk(v1[2], v1[3]);
                    *(u32x4*)(rowp + 8 * bj) = w; }
            }
    }
};
__device__ __forceinline__ f32x4 gate4(unsigned w) { f32x4 g; g[0] = (float)(w & 0xffu); g[1] = (float)((w >> 8) & 0xffu); g[2] = (float)((w >> 16) & 0xffu); g[3] = (float)(w >> 24);
    g[0] = fmaxf(g[0], 1e-3f); g[1] = fmaxf(g[1], 1e-3f); g[2] = fmaxf(g[2], 1e-3f); g[3] = fmaxf(g[3], 1e-3f); return g; }
struct EpiMerge {
    __device__ __forceinline__ bool reset_after(const Unit& u) const { return u.seg == 2; }
    const unsigned char* G; bf16_t* MERGED;
    __device__ __forceinline__ void operator()(Acc& acc, const Unit& u, int wr, int wc, int fr, int fq) const {
        const int row0 = u.pm * 256 + wr * 64 + fr, col = u.pn * 256 + wc * 64 + fq * 16;
        const unsigned char* gbase = G + (size_t)row0 * GP + u.seg * 1024 + col;
        u32x4 gn[8], gd[8];
#pragma unroll
        for (int i = 0; i < 8; ++i) gn[i] = *(const u32x4*)(gbase + (size_t)((i >> 2) * 128 + (i & 3) * 16) * GP);
        if (u.seg < 2) {
#pragma unroll
            for (int i = 0; i < 8; ++i) gd[i] = *(const u32x4*)(gbase + (size_t)((i >> 2) * 128 + (i & 3) * 16) * GP + 1024);
        }
        asm volatile("" ::: "memory");
#pragma unroll
        for (int ai = 0; ai < 2; ++ai)
#pragma unroll
            for (int m = 0; m < 4; ++m) {
                const size_t row = (size_t)(row0 + ai * 128 + m * 16);
                const u32x4 gnw = gn[ai * 4 + m];
                if (u.seg < 2) {
                    const u32x4 gdw = gd[ai * 4 + m];
#pragma unroll
                    for (int bj = 0; bj < 2; ++bj)
#pragma unroll
                        for (int n = 0; n < 2; ++n) { const f32x4 a_ = gate4(gnw[2 * bj + n]), d_ = gate4(gdw[2 * bj + n]); f32x4 r;
                            r[0] = a_[0] * fast_rcp(d_[0]); r[1] = a_[1] * fast_rcp(d_[1]); r[2] = a_[2] * fast_rcp(d_[2]); r[3] = a_[3] * fast_rcp(d_[3]);
                            acc[ai][bj][m][n] *= r; }
                } else {
                    bf16_t* mp = MERGED + row * DM + col;
#pragma unroll
                    for (int bj = 0; bj < 2; ++bj) {
                        const f32x4 v0 = acc[ai][bj][m][0] * gate4(gnw[2 * bj]) * (1.f / 255.f), v1 = acc[ai][bj][m][1] * gate4(gnw[2 * bj + 1]) * (1.f / 255.f);
                        u32x4 w; w.x = cvtpk(v0[0], v0[1]); w.y = cvtpk(v0[2], v0[3]); w.z = cvtpk(v1[0], v1[1]); w.w = cvtpk(v1[2], v1[3]);
                        *(u32x4*)(mp + 8 * bj) = w; }
                }
            }
    }
};
struct EpiOut {
    __device__ __forceinline__ bool reset_after(const Unit&) const { return true; }
    const float* X; float* OUT; bf16_t* X1B; float* SS;
    __device__ __forceinline__ void operator()(const Acc& acc, const Unit& u, int wr, int wc, int fr, int fq) const {
        const int row0 = u.pm * 256 + wr * 64 + fr, col = u.pn * 256 + wc * 64 + fq * 16;
        f32x4 xv[4][4];
#pragma unroll
        for (int i = 0; i < 4; ++i) { const float* xp = X + (size_t)(row0 + i * 16) * DM + col;
#pragma unroll
            for (int q = 0; q < 4; ++q) xv[i][q] = *(const f32x4*)(xp + 4 * q); }
        asm volatile("" ::: "memory");
#pragma unroll
        for (int i = 0; i < 8; ++i) {
            const int ai = i >> 2, m = i & 3;
            const size_t row = (size_t)(row0 + ai * 128 + m * 16);
            float ss = 0.f;
#pragma unroll
            for (int bj = 0; bj < 2; ++bj) {
                const f32x4 v0 = acc[ai][bj][m][0] + xv[i & 3][2 * bj], v1 = acc[ai][bj][m][1] + xv[i & 3][2 * bj + 1];
                ss += (v0[0] * v0[0] + v0[1] * v0[1]) + (v0[2] * v0[2] + v0[3] * v0[3]) + (v1[0] * v1[0] + v1[1] * v1[1]) + (v1[2] * v1[2] + v1[3] * v1[3]);
                u32x4 w; w.x = cvtpk(v0[0], v0[1]); w.y = cvtpk(v0[2], v0[3]); w.z = cvtpk(v1[0], v1[1]); w.w = cvtpk(v1[2], v1[3]);
                *(u32x4*)(X1B + row * DM + col + 8 * bj) = w;
            }
            if (i < 4) { const float* xp = X + (size_t)(row0 + 128 + i * 16) * DM + col;
#pragma unroll
                for (int q = 0; q < 4; ++q) xv[i][q] = *(const f32x4*)(xp + 4 * q); }
            ss = sum_fq(ss);
            if (fq == 0) atomicAdd(SS + row, ss);
        }
    }
};
struct EpiUp {
    __device__ __forceinline__ bool reset_after(const Unit&) const { return true; }
    const float* SS; const float* cw; const float* cb; bf16_t* ACT; float* UB;
    __device__ __forceinline__ void operator()(const Acc& acc, const Unit& u, int wr, int wc, int fr, int fq) const {
        const int T0 = u.pm * 256 + wr * 128 + fr * 8, grp = u.pm * 2 + wr, ch0 = u.pn * 128 + wc * 32 + fq * 8;
        const f32x4 sA = *(const f32x4*)(SS + T0), sB = *(const f32x4*)(SS + T0 + 4);
        const float r0 = rsqrtf(sA[0] * (1.f / 1024.f) + EPS), r1 = rsqrtf(sA[1] * (1.f / 1024.f) + EPS), r2 = rsqrtf(sA[2] * (1.f / 1024.f) + EPS), r3 = rsqrtf(sA[3] * (1.f / 1024.f) + EPS);
        const float r4 = rsqrtf(sB[0] * (1.f / 1024.f) + EPS), r5 = rsqrtf(sB[1] * (1.f / 1024.f) + EPS), r6 = rsqrtf(sB[2] * (1.f / 1024.f) + EPS), r7 = rsqrtf(sB[3] * (1.f / 1024.f) + EPS);
        bf16_t* actp = ACT + (size_t)T0 * DFF + ch0;
        float* ubp = UB + ((size_t)grp * DFF + ch0) * 8 + (fr == 15 ? 4 : 0);
#pragma unroll
        for (int n = 0; n < 2; ++n) {
            f32x4 cwa[3], cwg[3];
#pragma unroll
            for (int k = 0; k < 3; ++k) { cwa[k] = *(const f32x4*)(cw + k * UPN + ch0 + 4 * n); cwg[k] = *(const f32x4*)(cw + k * UPN + DFF + ch0 + 4 * n); }
            const f32x4 cba = *(const f32x4*)(cb + ch0 + 4 * n), cbg = *(const f32x4*)(cb + DFF + ch0 + 4 * n);
            unsigned pk[8][2];
#pragma unroll
            for (int jp = 0; jp < 2; ++jp) {
                float res[2][8];
#pragma unroll
                for (int jj = 0; jj < 2; ++jj) {
                    const int j = 2 * jp + jj;
                    const f32x2 w0 = (f32x2){cwa[0][j], cwg[0][j]}, w1 = (f32x2){cwa[1][j], cwg[1][j]}, w2 = (f32x2){cwa[2][j], cwg[2][j]}, bb = (f32x2){cba[j], cbg[j]};
                    const f32x2 x0 = (f32x2){acc[0][0][0][n][j], acc[0][1][0][n][j]} * r0, x1 = (f32x2){acc[0][0][1][n][j], acc[0][1][1][n][j]} * r1;
                    const f32x2 x2 = (f32x2){acc[0][0][2][n][j], acc[0][1][2][n][j]} * r2, x3 = (f32x2){acc[0][0][3][n][j], acc[0][1][3][n][j]} * r3;
                    const f32x2 x4 = (f32x2){acc[1][0][0][n][j], acc[1][1][0][n][j]} * r4, x5 = (f32x2){acc[1][0][1][n][j], acc[1][1][1][n][j]} * r5;
                    const f32x2 x6 = (f32x2){acc[1][0][2][n][j], acc[1][1][2][n][j]} * r6, x7 = (f32x2){acc[1][0][3][n][j], acc[1][1][3][n][j]} * r7;
                    const f32x2 xm2 = (f32x2){dpp_shr1(x6[0]), dpp_shr1(x6[1])}, xm1 = (f32x2){dpp_shr1(x7[0]), dpp_shr1(x7[1])};
                    if (fr == 0) *(f32x4*)(ubp + (4 * n + j) * 8) = (f32x4){x0[0], x0[1], x1[0], x1[1]};
                    if (fr == 15) *(f32x4*)(ubp + (4 * n + j) * 8) = (f32x4){x6[0], x6[1], x7[0], x7[1]};
#define UPC(r, p2, p1, p0) do { const f32x2 c_ = w0 * (p2) + (w1 * (p1) + (w2 * (p0) + bb)); res[jj][r] = c_[0] * sigmoidf_(c_[0]) * c_[1]; } while (0)
                    UPC(0, xm2, xm1, x0); UPC(1, xm1, x0, x1); UPC(2, x0, x1, x2); UPC(3, x1, x2, x3);
                    UPC(4, x2, x3, x4); UPC(5, x3, x4, x5); UPC(6, x4, x5, x6); UPC(7, x5, x6, x7);
#undef UPC
                }
#pragma unroll
                for (int r = 0; r < 8; ++r) pk[r][jp] = cvtpk(res[0][r], res[1][r]);
            }
#pragma unroll
            for (int r = 0; r < 8; ++r) {
                if (fr == 0 && r < 2) continue;
                *(u32x2*)(actp + (size_t)r * DFF + 4 * n) = (u32x2){pk[r][0], pk[r][1]};
            }
        }
    }
};
struct EpiDown {
    __device__ __forceinline__ bool reset_after(const Unit&) const { return true; }
    float* OUT; const bf16_t* X1B;
    __device__ __forceinline__ void operator()(const Acc& acc, const Unit& u, int wr, int wc, int fr, int fq) const {
        const int row0 = u.pm * 256 + wr * 64 + fr, col = u.pn * 256 + wc * 64 + fq * 16;
        u32x4 t[8][2];
#pragma unroll
        for (int i = 0; i < 8; ++i) { const size_t off = (size_t)(row0 + (i >> 2) * 128 + (i & 3) * 16) * DM + col; t[i][0] = *(const u32x4*)(X1B + off); t[i][1] = *(const u32x4*)(X1B + off + 8); }
        asm volatile("" ::: "memory");
#pragma unroll
        for (int ai = 0; ai < 2; ++ai)
#pragma unroll
            for (int m = 0; m < 4; ++m) {
                const size_t off = (size_t)(row0 + ai * 128 + m * 16) * DM + col;
                float* op = OUT + off;
#pragma unroll
                for (int bj = 0; bj < 2; ++bj) {
                    const u32x4 tw = t[ai * 4 + m][bj];
                    f32x4 v0 = acc[ai][bj][m][0], v1 = acc[ai][bj][m][1];
                    v0[0] += bflo(tw.x); v0[1] += bfhi(tw.x); v0[2] += bflo(tw.y); v0[3] += bfhi(tw.y);
                    v1[0] += bflo(tw.z); v1[1] += bfhi(tw.z); v1[2] += bflo(tw.w); v1[3] += bfhi(tw.w);
                    *(f32x4*)(op + 8 * bj) = v0; *(f32x4*)(op + 8 * bj + 4) = v1; }
            }
    }
};

struct AttnP {
    const bf16_t* QK; const bf16_t* VT; const bf16_t* MK; const bf16_t* MVT; const float* C2; bf16_t* O; float* S0;
    const float* lq1; const float* lk1; const float* lq2; const float* lk2; const float* subln; const float* mqn; const float* mkn; const float* GN;
};
__device__ __forceinline__ float max3f_(float a, float b, float c) { float r; asm("v_max3_f32 %0, %1, %2, %3" : "=v"(r) : "v"(a), "v"(b), "v"(c)); return r; }
constexpr int AT_KOFF = 0, AT_VOFF = 17408, AT_COFF = 35840, AT_BUF = 36096, AT_UNITW = 3 * AT_BUF;

template <int KIND>
__device__ __forceinline__ void attn_unit(LAS unsigned char* lds, const AttnP& P, int b, int head, int qb) {
    constexpr int DK = KIND == 2 ? 128 : 64, DV = KIND == 1 ? 64 : 128, NST = DK / 16, NDB = DV / 32;
    constexpr int KPITCH = DK * 2 + 16, VPITCH = 144;
    constexpr int NPASS = KIND == 0 ? 2 : 1;
    constexpr int KLD = DK / 64, VLD = DV / 64;
    int tid = threadIdx.x; asm volatile("" : "+v"(tid));
    const int lane = tid & 63, wid = __builtin_amdgcn_readfirstlane(tid >> 6), r32 = lane & 31, h = lane >> 5;
    const int q0 = qb * 256, qrow = q0 + wid * 32 + r32;
    const size_t tok0 = (size_t)b * SEQ;
    const int nkt = KIND == 2 ? 4 : (q0 + 256) / 64;
    const int wlast = KIND == 2 ? 3 : (q0 + wid * 32) / 64;
    float lam = 0.f;
    if (KIND == 0) {
        float v1 = P.lq1[lane] * P.lk1[lane], v2 = P.lq2[lane] * P.lk2[lane];
        v1 = wave_sum(v1); v2 = wave_sum(v2);
        lam = __expf(v1) - __expf(v2) + 0.2f;
    }
    const float sl2 = KIND == 0 ? LOG2E * exp2f(-2.f * (float)(head + 1)) : 0.f;
    int nit = nkt, ktw = 0;
    if (KIND == 0) {
        float gq = fabsf(P.GN[lane]), gk = fabsf(P.GN[64 + lane]);
#pragma unroll
        for (int o = 1; o < 64; o <<= 1) { gq = fmaxf(gq, __shfl_xor(gq, o)); gk = fmaxf(gk, __shfl_xor(gk, o)); }
        const float B = 1.03f * 64.f * gq * gk;
        const float dmax = (B + 134.f) / sl2;
        int ktm = (int)ceilf(((float)(q0 - 63) - dmax) * (1.f / 64.f));
        ktm = ktm < 0 ? 0 : ktm;
        nit = __builtin_amdgcn_readfirstlane(nkt - ktm);
        if (nit < 1) nit = 1;
        int kw = (int)ceilf(((float)(q0 + wid * 32 - 63) - dmax) * (1.f / 64.f));
        ktw = __builtin_amdgcn_readfirstlane(kw < 0 ? 0 : kw);
    }
#pragma unroll 1
    for (int pass = 0; pass < NPASS; ++pass) {
        const bf16_t *Qp, *Kp, *VTp; int kpitch, vtpitch;
        if (KIND == 0) { Qp = P.QK + tok0 * QKP + head * 128 + pass * 64; Kp = P.QK + tok0 * QKP + 512 + head * 128 + pass * 64; kpitch = QKP; VTp = P.VT + (size_t)(head * 128) * NTOK + tok0; vtpitch = NTOK; }
        else if (KIND == 1) { Qp = P.QK + tok0 * QKP + 1024 + head * 64; Kp = P.QK + tok0 * QKP + 1536 + head * 64; kpitch = QKP; VTp = P.VT + (size_t)(512 + head * 64) * NTOK + tok0; vtpitch = NTOK; }
        else { Qp = P.QK + tok0 * QKP + 2048 + head * 128; Kp = P.MK + (size_t)(b * NMEM) * 512 + head * 128; kpitch = 512; VTp = P.MVT + (size_t)(head * 128) * NMTOK + b * NMEM; vtpitch = NMTOK; }
        bf16x8 qf[NST];
#pragma unroll
        for (int st = 0; st < NST; ++st) qf[st] = *(const bf16x8*)(Qp + (size_t)qrow * QKP + 16 * st + 8 * h);
        if (KIND == 2) {
            float ss = 0.f;
#pragma unroll
            for (int st = 0; st < NST; ++st)
#pragma unroll
                for (int j = 0; j < 8; ++j) { const float v = bf2f((unsigned short)qf[st][j]); ss += v * v; }
            ss += __shfl_xor(ss, 32);
            const float rs = rsqrtf(ss * (1.f / 128.f) + EPS) * (0.08838834764831845f * LOG2E);
#pragma unroll
            for (int st = 0; st < NST; ++st) {
                const f32x4 g0 = *(const f32x4*)(P.mqn + 16 * st + 8 * h), g1 = *(const f32x4*)(P.mqn + 16 * st + 8 * h + 4);
                u32x4 w;
                w.x = cvtpk(bf2f((unsigned short)qf[st][0]) * rs * g0[0], bf2f((unsigned short)qf[st][1]) * rs * g0[1]);
                w.y = cvtpk(bf2f((unsigned short)qf[st][2]) * rs * g0[2], bf2f((unsigned short)qf[st][3]) * rs * g0[3]);
                w.z = cvtpk(bf2f((unsigned short)qf[st][4]) * rs * g1[0], bf2f((unsigned short)qf[st][5]) * rs * g1[1]);
                w.w = cvtpk(bf2f((unsigned short)qf[st][6]) * rs * g1[2], bf2f((unsigned short)qf[st][7]) * rs * g1[3]);
                qf[st] = __builtin_bit_cast(bf16x8, w);
            }
        }
        float m_ref = 0.f, l_run = 0.f;
        f32x16 oT[NDB];
#pragma unroll
        for (int db = 0; db < NDB; ++db)
#pragma unroll
            for (int r = 0; r < 16; ++r) oT[db][r] = 0.f;
        u32x4 kreg[KLD], vreg[VLD]; float creg = 0.f;
#define AT_LOAD(kt) do { const int k0_ = (kt) * 64; \
        _Pragma("unroll") for (int i = 0; i < KLD; ++i) { const int idx = tid + 512 * i, row = idx / (DK / 8), chn = idx % (DK / 8); kreg[i] = *(const u32x4*)(Kp + (size_t)(k0_ + row) * kpitch + chn * 8); } \
        _Pragma("unroll") for (int i = 0; i < VLD; ++i) { const int idx = tid + 512 * i, row = idx >> 3, chn = idx & 7; vreg[i] = *(const u32x4*)(VTp + (size_t)row * vtpitch + k0_ + chn * 8); } \
        if (KIND == 1 && tid < 64) creg = P.C2[(size_t)(b * 8 + head) * SEQ + k0_ + tid]; } while (0)
#define AT_STORE(bufi) do { LAS unsigned char* bb = lds + (bufi) * AT_BUF; \
        _Pragma("unroll") for (int i = 0; i < KLD; ++i) { const int idx = tid + 512 * i, row = idx / (DK / 8), chn = idx % (DK / 8); u32x4 kv = kreg[i]; \
            if (KIND == 2) { float f[8]; f[0] = bflo(kv.x); f[1] = bfhi(kv.x); f[2] = bflo(kv.y); f[3] = bfhi(kv.y); f[4] = bflo(kv.z); f[5] = bfhi(kv.z); f[6] = bflo(kv.w); f[7] = bfhi(kv.w); \
                float ss = 0.f; _Pragma("unroll") for (int e = 0; e < 8; ++e) ss += f[e] * f[e]; \
                ss += __shfl_xor(ss, 1); ss += __shfl_xor(ss, 2); ss += __shfl_xor(ss, 4); ss += __shfl_xor(ss, 8); \
                const float rs = rsqrtf(ss * (1.f / 128.f) + EPS); const f32x4 g0 = *(const f32x4*)(P.mkn + chn * 8), g1 = *(const f32x4*)(P.mkn + chn * 8 + 4); \
                kv.x = cvtpk(f[0] * rs * g0[0], f[1] * rs * g0[1]); kv.y = cvtpk(f[2] * rs * g0[2], f[3] * rs * g0[3]); kv.z = cvtpk(f[4] * rs * g1[0], f[5] * rs * g1[1]); kv.w = cvtpk(f[6] * rs * g1[2], f[7] * rs * g1[3]); } \
            *(LAS u32x4*)(bb + AT_KOFF + row * KPITCH + chn * 16) = kv; } \
        _Pragma("unroll") for (int i = 0; i < VLD; ++i) { const int idx = tid + 512 * i, row = idx >> 3, chn = idx & 7; LAS unsigned char* vp_ = bb + AT_VOFF + row * VPITCH + (chn >> 1) * 32 + (chn & 1) * 8; \
            *(LAS u32x2*)vp_ = (u32x2){vreg[i].x, vreg[i].y}; *(LAS u32x2*)(vp_ + 16) = (u32x2){vreg[i].z, vreg[i].w}; } \
        if (KIND == 1 && tid < 64) *(LAS float*)(bb + AT_COFF + tid * 4) = creg; } while (0)
        AT_LOAD(nkt - 1); AT_STORE(0);
        __syncthreads();
#define AT_PV(bufp) do { const LAS unsigned char* vb_ = (bufp) + AT_VOFF + r32 * VPITCH + h * 16; \
        _Pragma("unroll") for (int dp = 0; dp < NDB / 2; ++dp) { bf16x8 va[2][4]; \
            _Pragma("unroll") for (int d2 = 0; d2 < 2; ++d2) _Pragma("unroll") for (int kk = 0; kk < 4; ++kk) va[d2][kk] = *(const LAS bf16x8*)(vb_ + (2 * dp + d2) * 32 * VPITCH + kk * 32); \
            __builtin_amdgcn_sched_barrier(0); \
            _Pragma("unroll") for (int kk = 0; kk < 4; ++kk) _Pragma("unroll") for (int d2 = 0; d2 < 2; ++d2) oT[2 * dp + d2] = __builtin_amdgcn_mfma_f32_32x32x16_bf16(va[d2][kk], pf[kk], oT[2 * dp + d2], 0, 0, 0); \
            __builtin_amdgcn_sched_barrier(0); } } while (0)
        const bool lateB = false;
        bool have_prev = false; int prev_buf = 0, bi = 0;
        bf16x8 pf[4];
#pragma unroll
        for (int i = 0; i < 4; ++i) pf[i] = (bf16x8){0, 0, 0, 0, 0, 0, 0, 0};
#pragma unroll 1
        for (int it = 0; it < nit; ++it) {
            const int kt = nkt - 1 - it;
            if (it + 1 < nit) AT_LOAD(kt - 1);
            if (lateB && have_prev) { AT_PV(lds + prev_buf * AT_BUF); }
            if (kt <= wlast && kt >= ktw) {
                const LAS unsigned char* buf = lds + bi * AT_BUF;
                const int k0 = kt * 64;
                f32x16 s0, s1;
                if (KIND == 0 && kt < wlast) {
                    const float nb = -m_ref - sl2 * (float)(qrow - k0 - 4 * h);
#pragma unroll
                    for (int r = 0; r < 16; ++r) { const float o = (float)((r & 3) + 8 * (r >> 2)); s0[r] = fmaf(sl2, o, nb); s1[r] = fmaf(sl2, o + 32.f, nb); }
                } else if (KIND == 1) {
                    const LAS float* cs = (const LAS float*)(buf + AT_COFF);
#pragma unroll
                    for (int g = 0; g < 4; ++g) { const f32x4 c0 = *(const LAS f32x4*)(cs + 8 * g + 4 * h), c1 = *(const LAS f32x4*)(cs + 32 + 8 * g + 4 * h);
#pragma unroll
                        for (int i = 0; i < 4; ++i) { s0[4 * g + i] = -m_ref - c0[i]; s1[4 * g + i] = -m_ref - c1[i]; } }
                } else {
#pragma unroll
                    for (int r = 0; r < 16; ++r) { s0[r] = -m_ref; s1[r] = -m_ref; }
                }
                const LAS unsigned char* kb_ = buf + AT_KOFF + r32 * KPITCH + h * 16;
#pragma unroll
                for (int sg = 0; sg < NST / 4; ++sg) {
                    bf16x8 ka[4][2];
#pragma unroll
                    for (int st = 0; st < 4; ++st) { ka[st][0] = *(const LAS bf16x8*)(kb_ + (4 * sg + st) * 32); ka[st][1] = *(const LAS bf16x8*)(kb_ + 32 * KPITCH + (4 * sg + st) * 32); }
                    __builtin_amdgcn_sched_barrier(0);
#pragma unroll
                    for (int st = 0; st < 4; ++st) {
                        s0 = __builtin_amdgcn_mfma_f32_32x32x16_bf16(ka[st][0], qf[4 * sg + st], s0, 0, 0, 0);
                        s1 = __builtin_amdgcn_mfma_f32_32x32x16_bf16(ka[st][1], qf[4 * sg + st], s1, 0, 0, 0);
                    }
                    __builtin_amdgcn_sched_barrier(0);
                }
                if (KIND == 1) {
                    if (kt == wlast) {
#pragma unroll
                        for (int r = 0; r < 16; ++r) { const int kv = k0 + (r & 3) + 8 * (r >> 2) + 4 * h; if (kv > qrow) s0[r] = -INFINITY; if (kv + 32 > qrow) s1[r] = -INFINITY; }
                    }
                }
                if (KIND == 0 && kt == wlast) {
                    const float dq = (float)(qrow - k0 - 4 * h);
#pragma unroll
                    for (int r = 0; r < 16; ++r) { const float o = (float)((r & 3) + 8 * (r >> 2)); s0[r] = fmaf(-sl2, fabsf(dq - o), s0[r]); s1[r] = fmaf(-sl2, fabsf(dq - o - 32.f), s1[r]); }
                }
                float mx = max3f_(s0[0], s1[0], s0[1]), mxb = max3f_(s1[1], s0[2], s1[2]);
#pragma unroll
                for (int r = 3; r < 15; r += 2) { mx = max3f_(mx, s0[r], s1[r]); mxb = max3f_(mxb, s0[r + 1], s1[r + 1]); }
                mx = max3f_(mx, s0[15], s1[15]); mx = max3f_(mx, mxb, mxb);
                { const auto rr = __builtin_amdgcn_permlane32_swap(__float_as_uint(mx), __float_as_uint(mx), false, false); mx = max3f_(__uint_as_float(rr[0]), __uint_as_float(rr[1]), __uint_as_float(rr[1])); }
                if (!(KIND == 0 && __all(mx < -134.f))) {
                if (__any(mx > 8.f)) {
                    const float dl = fmaxf(mx, 0.f), f = fast_exp2(-dl);
                    m_ref += dl; l_run *= f;
#pragma unroll
                    for (int r = 0; r < 16; ++r) { s0[r] -= dl; s1[r] -= dl; }
#pragma unroll
                    for (int db = 0; db < NDB; ++db)
#pragma unroll
                        for (int r = 0; r < 16; ++r) oT[db][r] *= f;
                }
                const LAS unsigned char* vb0_ = buf + AT_VOFF + r32 * VPITCH + h * 16;
                bf16x8 va0[2][4];
#pragma unroll
                for (int d2 = 0; d2 < 2; ++d2)
#pragma unroll
                    for (int kk = 0; kk < 4; ++kk) va0[d2][kk] = *(const LAS bf16x8*)(vb0_ + d2 * 32 * VPITCH + kk * 32);
                __builtin_amdgcn_sched_barrier(0);
                f32x2 rs2 = (f32x2){0.f, 0.f};
#pragma unroll
                for (int r = 0; r < 16; ++r) { s0[r] = fast_exp2(s0[r]); s1[r] = fast_exp2(s1[r]); }
#pragma unroll
                for (int r = 0; r < 16; r += 2) { rs2 += (f32x2){s0[r], s0[r + 1]}; rs2 += (f32x2){s1[r], s1[r + 1]}; }
                l_run += rs2[0] + rs2[1];
                { u32x4 w;
                  w.x = cvtpk(s0[0], s0[1]); w.y = cvtpk(s0[2], s0[3]); w.z = cvtpk(s0[4], s0[5]); w.w = cvtpk(s0[6], s0[7]); pf[0] = __builtin_bit_cast(bf16x8, w);
                  w.x = cvtpk(s0[8], s0[9]); w.y = cvtpk(s0[10], s0[11]); w.z = cvtpk(s0[12], s0[13]); w.w = cvtpk(s0[14], s0[15]); pf[1] = __builtin_bit_cast(bf16x8, w);
                  w.x = cvtpk(s1[0], s1[1]); w.y = cvtpk(s1[2], s1[3]); w.z = cvtpk(s1[4], s1[5]); w.w = cvtpk(s1[6], s1[7]); pf[2] = __builtin_bit_cast(bf16x8, w);
                  w.x = cvtpk(s1[8], s1[9]); w.y = cvtpk(s1[10], s1[11]); w.z = cvtpk(s1[12], s1[13]); w.w = cvtpk(s1[14], s1[15]); pf[3] = __builtin_bit_cast(bf16x8, w); }
                __builtin_amdgcn_sched_barrier(0);
#pragma unroll
                for (int kk = 0; kk < 4; ++kk)
#pragma unroll
                    for (int d2 = 0; d2 < 2; ++d2) oT[d2] = __builtin_amdgcn_mfma_f32_32x32x16_bf16(va0[d2][kk], pf[kk], oT[d2], 0, 0, 0);
                __builtin_amdgcn_sched_barrier(0);
                if (NDB == 4) {
                    bf16x8 va1[2][4];
#pragma unroll
                    for (int d2 = 0; d2 < 2; ++d2)
#pragma unroll
                        for (int kk = 0; kk < 4; ++kk) va1[d2][kk] = *(const LAS bf16x8*)(vb0_ + (2 + d2) * 32 * VPITCH + kk * 32);
                    __builtin_amdgcn_sched_barrier(0);
#pragma unroll
                    for (int kk = 0; kk < 4; ++kk)
#pragma unroll
                        for (int d2 = 0; d2 < 2; ++d2) oT[NDB - 2 + d2] = __builtin_amdgcn_mfma_f32_32x32x16_bf16(va1[d2][kk], pf[kk], oT[NDB - 2 + d2], 0, 0, 0);
                    __builtin_amdgcn_sched_barrier(0);
                }
                }
            }
            if (lateB) { have_prev = (kt <= wlast); prev_buf = bi; }
            const int bn = bi == 2 ? 0 : bi + 1;
            if (it + 1 < nit) AT_STORE(bn);
            bi = bn;
            __syncthreads();
        }
        if (lateB && have_prev) { AT_PV(lds + prev_buf * AT_BUF); }
        __syncthreads();
#undef AT_PV
#undef AT_LOAD
#undef AT_STORE
        const float l = l_run + __shfl_xor(l_run, 32), inv = 1.f / l;
        float* sp = P.S0 + (tok0 + qrow) * 512 + head * 128 + 4 * h;
        if (KIND == 0 && pass == 0) {
#pragma unroll
            for (int db = 0; db < NDB; ++db)
#pragma unroll
                for (int g = 0; g < 4; ++g) { f32x4 v; v[0] = oT[db][4 * g] * inv; v[1] = oT[db][4 * g + 1] * inv; v[2] = oT[db][4 * g + 2] * inv; v[3] = oT[db][4 * g + 3] * inv; *(f32x4*)(sp + 32 * db + 8 * g) = v; }
        } else {
            float rs = inv;
            if (KIND == 0) {
                float ss = 0.f; const float li = lam * inv;
#pragma unroll
                for (int db = 0; db < NDB; ++db)
#pragma unroll
                    for (int g = 0; g < 4; ++g) { const f32x4 o0 = *(const f32x4*)(sp + 32 * db + 8 * g);
#pragma unroll
                        for (int i = 0; i < 4; ++i) { const float v = o0[i] - li * oT[db][4 * g + i]; oT[db][4 * g + i] = v; ss += v * v; } }
                ss += __shfl_xor(ss, 32);
                rs = rsqrtf(ss * (1.f / 128.f) + EPS) * 0.8f;
            }
            const int obase = KIND == 0 ? 0 : (KIND == 1 ? 1 : 2);
            bf16_t* op = P.O + (size_t)obase * NTOK * 512 + (tok0 + qrow) * 512 + head * DV + 4 * h;
#pragma unroll
            for (int db = 0; db < NDB; ++db)
#pragma unroll
                for (int g = 0; g < 4; ++g) {
                    f32x4 mu = (f32x4){rs, rs, rs, rs};
                    if (KIND == 0) mu = mu * *(const f32x4*)(P.subln + 32 * db + 8 * g + 4 * h);
                    u32x2 w; w.x = cvtpk(oT[db][4 * g] * mu[0], oT[db][4 * g + 1] * mu[1]); w.y = cvtpk(oT[db][4 * g + 2] * mu[2], oT[db][4 * g + 3] * mu[3]);
                    *(u32x2*)(op + 32 * db + 8 * g) = w; }
        }
    }
}

__device__ __forceinline__ void attn_fx64(LAS unsigned char* lds, const AttnP& P, int b, int head, int qb) {
    constexpr int KPITCH = 144, VPITCH = 144;
    int tid = threadIdx.x; asm volatile("" : "+v"(tid));
    const int lane = tid & 63, wid = __builtin_amdgcn_readfirstlane(tid >> 6), r32 = lane & 31, h = lane >> 5;
    const int q0 = qb * 512, qA = q0 + wid * 64 + r32, qB = qA + 32;
    const size_t tok0 = (size_t)b * SEQ;
    const int nkt = (q0 + 512) / 64, wlast = (q0 >> 6) + wid;
    const bf16_t* Qp = P.QK + tok0 * QKP + 1024 + head * 64;
    const bf16_t* Kp = P.QK + tok0 * QKP + 1536 + head * 64;
    const bf16_t* VTp = P.VT + (size_t)(512 + head * 64) * NTOK + tok0;
    const float* C2p = P.C2 + (size_t)(b * 8 + head) * SEQ;
    bf16x8 qfA[4], qfB[4];
#pragma unroll
    for (int st = 0; st < 4; ++st) { qfA[st] = *(const bf16x8*)(Qp + (size_t)qA * QKP + 16 * st + 8 * h); qfB[st] = *(const bf16x8*)(Qp + (size_t)qB * QKP + 16 * st + 8 * h); }
    float mA = 0.f, mB = 0.f, lA = 0.f, lB = 0.f;
    f32x16 oA[2], oB[2];
#pragma unroll
    for (int d = 0; d < 2; ++d)
#pragma unroll
        for (int r = 0; r < 16; ++r) { oA[d][r] = 0.f; oB[d][r] = 0.f; }
    u32x4 kreg, vreg; float creg = 0.f;
    const int srow = tid >> 3, schn = tid & 7;
#define FX_LOAD(kt) do { const int k0_ = (kt) * 64; kreg = *(const u32x4*)(Kp + (size_t)(k0_ + srow) * QKP + schn * 8); vreg = *(const u32x4*)(VTp + (size_t)srow * NTOK + k0_ + schn * 8); \
        if (tid < 64) creg = C2p[k0_ + tid]; } while (0)
#define FX_STORE(bufi) do { LAS unsigned char* bb = lds + (bufi) * AT_BUF; *(LAS u32x4*)(bb + AT_KOFF + srow * KPITCH + schn * 16) = kreg; \
        LAS unsigned char* vp_ = bb + AT_VOFF + srow * VPITCH + (schn >> 1) * 32 + (schn & 1) * 8; *(LAS u32x2*)vp_ = (u32x2){vreg.x, vreg.y}; *(LAS u32x2*)(vp_ + 16) = (u32x2){vreg.z, vreg.w}; \
        if (tid < 64) *(LAS float*)(bb + AT_COFF + tid * 4) = creg; } while (0)
#define FX_MAX(MX, S0, S1) do { float m_ = max3f_(S0[0], S1[0], S0[1]), n_ = max3f_(S1[1], S0[2], S1[2]); \
        _Pragma("unroll") for (int r = 3; r < 15; r += 2) { m_ = max3f_(m_, S0[r], S1[r]); n_ = max3f_(n_, S0[r + 1], S1[r + 1]); } \
        m_ = max3f_(m_, S0[15], S1[15]); m_ = max3f_(m_, n_, n_); \
        const auto rr_ = __builtin_amdgcn_permlane32_swap(__float_as_uint(m_), __float_as_uint(m_), false, false); MX = max3f_(__uint_as_float(rr_[0]), __uint_as_float(rr_[1]), __uint_as_float(rr_[1])); } while (0)
#define FX_EXP(S0, S1, L, PF) do { f32x2 rs2 = (f32x2){0.f, 0.f}; \
        _Pragma("unroll") for (int r = 0; r < 16; ++r) { S0[r] = fast_exp2(S0[r]); S1[r] = fast_exp2(S1[r]); } \
        _Pragma("unroll") for (int r = 0; r < 16; r += 2) { rs2 += (f32x2){S0[r], S0[r + 1]}; rs2 += (f32x2){S1[r], S1[r + 1]}; } \
        L += rs2[0] + rs2[1]; u32x4 w; \
        w.x = cvtpk(S0[0], S0[1]); w.y = cvtpk(S0[2], S0[3]); w.z = cvtpk(S0[4], S0[5]); w.w = cvtpk(S0[6], S0[7]); PF[0] = __builtin_bit_cast(bf16x8, w); \
        w.x = cvtpk(S0[8], S0[9]); w.y = cvtpk(S0[10], S0[11]); w.z = cvtpk(S0[12], S0[13]); w.w = cvtpk(S0[14], S0[15]); PF[1] = __builtin_bit_cast(bf16x8, w); \
        w.x = cvtpk(S1[0], S1[1]); w.y = cvtpk(S1[2], S1[3]); w.z = cvtpk(S1[4], S1[5]); w.w = cvtpk(S1[6], S1[7]); PF[2] = __builtin_bit_cast(bf16x8, w); \
        w.x = cvtpk(S1[8], S1[9]); w.y = cvtpk(S1[10], S1[11]); w.z = cvtpk(S1[12], S1[13]); w.w = cvtpk(S1[14], S1[15]); PF[3] = __builtin_bit_cast(bf16x8, w); } while (0)
    FX_LOAD(nkt - 1); FX_STORE(0);
    __syncthreads();
#pragma unroll 1
    for (int it = 0; it < nkt; ++it) {
        const int kt = nkt - 1 - it;
        if (it + 1 < nkt) FX_LOAD(kt - 1);
        if (kt <= wlast) {
            const LAS unsigned char* buf = lds + (it & 1) * AT_BUF;
            const int k0 = kt * 64;
            f32x16 a0, a1, b0, b1;
            {
                const LAS float* cs = (const LAS float*)(buf + AT_COFF);
#pragma unroll
                for (int g = 0; g < 4; ++g) { const f32x4 c0 = *(const LAS f32x4*)(cs + 8 * g + 4 * h), c1 = *(const LAS f32x4*)(cs + 32 + 8 * g + 4 * h);
#pragma unroll
                    for (int i = 0; i < 4; ++i) { a0[4 * g + i] = -mA - c0[i]; a1[4 * g + i] = -mA - c1[i]; b0[4 * g + i] = -mB - c0[i]; b1[4 * g + i] = -mB - c1[i]; } }
            }
            {
                const LAS unsigned char* kb_ = buf + AT_KOFF + r32 * KPITCH + h * 16;
                bf16x8 ka[4][2];
#pragma unroll
                for (int st = 0; st < 4; ++st) { ka[st][0] = *(const LAS bf16x8*)(kb_ + st * 32); ka[st][1] = *(const LAS bf16x8*)(kb_ + 32 * KPITCH + st * 32); }
                __builtin_amdgcn_sched_barrier(0);
#pragma unroll
                for (int st = 0; st < 4; ++st) {
                    a0 = __builtin_amdgcn_mfma_f32_32x32x16_bf16(ka[st][0], qfA[st], a0, 0, 0, 0);
                    b0 = __builtin_amdgcn_mfma_f32_32x32x16_bf16(ka[st][0], qfB[st], b0, 0, 0, 0);
                    a1 = __builtin_amdgcn_mfma_f32_32x32x16_bf16(ka[st][1], qfA[st], a1, 0, 0, 0);
                    b1 = __builtin_amdgcn_mfma_f32_32x32x16_bf16(ka[st][1], qfB[st], b1, 0, 0, 0);
                }
                __builtin_amdgcn_sched_barrier(0);
            }
            if (kt == wlast) {
#pragma unroll
                for (int r = 0; r < 16; ++r) { const int kv = k0 + (r & 3) + 8 * (r >> 2) + 4 * h;
                    if (kv > qA) a0[r] = -INFINITY; if (kv + 32 > qA) a1[r] = -INFINITY; if (kv > qB) b0[r] = -INFINITY; if (kv + 32 > qB) b1[r] = -INFINITY; }
            }
            float mxA, mxB; FX_MAX(mxA, a0, a1); FX_MAX(mxB, b0, b1);
            if (!__all(fmaxf(mxA, mxB) < -134.f)) {
            if (__any(fmaxf(mxA, mxB) > 8.f)) {
                const float dA = fmaxf(mxA, 0.f), dB = fmaxf(mxB, 0.f), fA = fast_exp2(-dA), fB = fast_exp2(-dB);
                mA += dA; mB += dB; lA *= fA; lB *= fB;
#pragma unroll
                for (int r = 0; r < 16; ++r) { a0[r] -= dA; a1[r] -= dA; b0[r] -= dB; b1[r] -= dB; }
#pragma unroll
                for (int d = 0; d < 2; ++d)
#pragma unroll
                    for (int r = 0; r < 16; ++r) { oA[d][r] *= fA; oB[d][r] *= fB; }
            }
            const LAS unsigned char* vb_ = buf + AT_VOFF + r32 * VPITCH + h * 16;
            bf16x8 va[2][4];
#pragma unroll
            for (int d2 = 0; d2 < 2; ++d2)
#pragma unroll
                for (int kk = 0; kk < 4; ++kk) va[d2][kk] = *(const LAS bf16x8*)(vb_ + d2 * 32 * VPITCH + kk * 32);
            __builtin_amdgcn_sched_barrier(0);
            bf16x8 pA[4], pB[4];
            FX_EXP(a0, a1, lA, pA);
            __builtin_amdgcn_sched_barrier(0);
#pragma unroll
            for (int kk = 0; kk < 4; ++kk)
#pragma unroll
                for (int d2 = 0; d2 < 2; ++d2) oA[d2] = __builtin_amdgcn_mfma_f32_32x32x16_bf16(va[d2][kk], pA[kk], oA[d2], 0, 0, 0);
            __builtin_amdgcn_sched_barrier(0);
            FX_EXP(b0, b1, lB, pB);
            __builtin_amdgcn_sched_barrier(0);
#pragma unroll
            for (int kk = 0; kk < 4; ++kk)
#pragma unroll
                for (int d2 = 0; d2 < 2; ++d2) oB[d2] = __builtin_amdgcn_mfma_f32_32x32x16_bf16(va[d2][kk], pB[kk], oB[d2], 0, 0, 0);
            __builtin_amdgcn_sched_barrier(0);
            }
        }
        if (it + 1 < nkt) FX_STORE((it + 1) & 1);
        __syncthreads();
    }
#undef FX_LOAD
#undef FX_STORE
#undef FX_MAX
#undef FX_EXP
    const float iA = 1.f / (lA + __shfl_xor(lA, 32)), iB = 1.f / (lB + __shfl_xor(lB, 32));
    bf16_t* opA = P.O + (size_t)NTOK * 512 + (tok0 + qA) * 512 + head * 64 + 4 * h;
    bf16_t* opB = opA + (size_t)32 * 512;
#pragma unroll
    for (int db = 0; db < 2; ++db)
#pragma unroll
        for (int g = 0; g < 4; ++g) {
            u32x2 w; w.x = cvtpk(oA[db][4 * g] * iA, oA[db][4 * g + 1] * iA); w.y = cvtpk(oA[db][4 * g + 2] * iA, oA[db][4 * g + 3] * iA); *(u32x2*)(opA + 32 * db + 8 * g) = w;
            u32x2 x; x.x = cvtpk(oB[db][4 * g] * iB, oB[db][4 * g + 1] * iB); x.y = cvtpk(oB[db][4 * g + 2] * iB, oB[db][4 * g + 3] * iB); *(u32x2*)(opB + 32 * db + 8 * g) = x; }
}

__device__ __forceinline__ void decode_unit(int idx, int& kind, int& qb, int& sub) {
    if (idx < 320) { kind = 0; qb = 7 - idx / 64; sub = idx % 64; }
    else if (idx < 448) { kind = 1; qb = 3; sub = idx - 320; }
    else if (idx < 512) { kind = 0; qb = 2; sub = idx - 448; }
    else if (idx < 640) { kind = 1; qb = 2; sub = idx - 512; }
    else if (idx < 704) { kind = 0; qb = 1; sub = idx - 640; }
    else if (idx < 832) { kind = 1; qb = 1; sub = idx - 704; }
    else if (idx < 896) { kind = 0; qb = 0; sub = idx - 832; }
    else if (idx < 1024) { kind = 1; qb = 0; sub = idx - 896; }
    else { kind = 2; const int t = idx - 1024; qb = t / 64; sub = t % 64; }
}
constexpr int N_ATT_UNITS = 1536;

__device__ __forceinline__ int inv_perm16(int L) { return ((L >> 3) & 1) * 128 + (L >> 6) * 32 + ((L >> 2) & 1) * 16 + ((L >> 4) & 3) * 4 + (L & 3); }
__device__ __forceinline__ int src_of(int mat, int lg) {
    switch (mat) {
    case 0: if (lg < 1024) return lg; if (lg < 2048) return 1536 + (lg - 1024); if (lg < 2560) return 3080 + (lg - 2048); return 3592 + (lg - 2560);
    case 1: return lg < 512 ? 1024 + lg : 2560 + (lg - 512);
    case 3: return 512 + lg;
    default: return lg;
    }
}
__device__ __forceinline__ int dst_of(int mat, int lg) {
    switch (mat) {
    case 1: case 3: return lg;
    case 8: { const int bj = lg >= DFF ? 1 : 0, chl = lg - bj * DFF, pn = chl >> 7, co = chl & 127;
              return pn * 256 + bj * 128 + (co >> 5) * 32 + ((co >> 2) & 1) * 16 + ((co >> 3) & 3) * 4 + (co & 3); }
    default: return (lg & ~255) + inv_perm16(lg & 255);
    }
}
__device__ __forceinline__ void transpose_item(const float* W, int K, int Npitch, bf16_t* WT, int nblk, int mat, const float* rowgain, LAS float* scr, int item, int lane) {
    const int kb = item / nblk, nb = item % nblk, k0 = 64 * kb, l0 = 32 * nb;
    const int sc = src_of(mat, l0 + (lane & 31));
    float t[32];
#pragma unroll
    for (int i = 0; i < 32; ++i) t[i] = W[(size_t)(k0 + 2 * i + (lane >> 5)) * Npitch + sc];
#pragma unroll
    for (int i = 0; i < 32; ++i) { const int kk = 2 * i + (lane >> 5); float v = t[i]; if (rowgain) v *= rowgain[k0 + kk]; scr[kk * 33 + (lane & 31)] = v; }
    asm volatile("s_waitcnt lgkmcnt(0)" ::: "memory");
    const int c = lane & 7;
#pragma unroll
    for (int j = 0; j < 4; ++j) { const int n = (lane >> 3) + 8 * j; const LAS float* sp = scr + (8 * c) * 33 + n;
        u32x4 o; o.x = cvtpk(sp[0 * 33], sp[1 * 33]); o.y = cvtpk(sp[2 * 33], sp[3 * 33]); o.z = cvtpk(sp[4 * 33], sp[5 * 33]); o.w = cvtpk(sp[6 * 33], sp[7 * 33]);
        *(u32x4*)(WT + (size_t)dst_of(mat, l0 + n) * K + k0 + 8 * c) = o; }
    asm volatile("s_waitcnt lgkmcnt(0)" ::: "memory");
}

#define XB_TMO      128
#define XB_XCNT(j)  (256  + 64 * (j))
#define XB_XSUB(j)  (1280 + 64 * (j))
#define XB_XGEN(j)  (2304 + 64 * (j))
#define XB_TOP      3328
#define XB_TOPGEN   3392
#define XCD_BAR_WORDS 3456
#define XB_SPIN_CAP (1u << 22)
__device__ __forceinline__ unsigned xb_ld(unsigned* p)              { return __hip_atomic_load(p, __ATOMIC_RELAXED, __HIP_MEMORY_SCOPE_AGENT); }
__device__ __forceinline__ unsigned xb_add(unsigned* p, unsigned v) { return __hip_atomic_fetch_add(p, v, __ATOMIC_RELAXED, __HIP_MEMORY_SCOPE_AGENT); }
__device__ __forceinline__ unsigned xb_xcc_id() { return (unsigned)__builtin_amdgcn_s_getreg((3 << 11) | 20) & 0xFu; }
#define XB_SPIN(cond, bar) do { unsigned _sp = 0; while (cond) { __builtin_amdgcn_s_sleep(1); \
    if ((++_sp & 255u) == 0u) { if (xb_ld(&(bar)[XB_TMO])) break; if (_sp > XB_SPIN_CAP) { atomicAdd(&(bar)[XB_TMO], 1u); break; } } } } while (0)
struct XcdBarrier { unsigned* bar; unsigned x; volatile LAS unsigned* st; };
__device__ __forceinline__ XcdBarrier xcd_barrier_post(unsigned* bar, volatile LAS unsigned* st) {
    XcdBarrier b; b.bar = bar; b.x = xb_xcc_id(); b.st = st;
    if (threadIdx.x == 0) (void)xb_add(&bar[XB_XCNT(b.x)], 1u);
    return b;
}
__device__ __forceinline__ void xcd_barrier_complete(unsigned* bar, unsigned x, unsigned& nloc, unsigned& nx) {
    const unsigned G = gridDim.x * gridDim.y * gridDim.z;
    unsigned sum, cnt, mine, sp = 0u;
    for (;;) {
        sum = 0u; cnt = 0u; mine = 0u;
#pragma unroll
        for (unsigned j = 0; j < 16; ++j) { const unsigned c = xb_ld(&bar[XB_XCNT(j)]); sum += c; cnt += (c > 0u) ? 1u : 0u; mine = (j == x) ? c : mine; }
        if (sum == G) break;
        __builtin_amdgcn_s_sleep(1);
        if ((++sp & 255u) == 0u) { if (xb_ld(&bar[XB_TMO])) break; if (sp > XB_SPIN_CAP) { atomicAdd(&bar[XB_TMO], 1u); break; } }
    }
    nloc = mine > 0u ? mine : 1u; nx = cnt > 0u ? cnt : 1u;
}
__device__ __forceinline__ void xcd_barrier(const XcdBarrier& b) {
    asm volatile("s_waitcnt vmcnt(0)" ::: "memory");
    __syncthreads();
    if (threadIdx.x == 0) {
        unsigned* bar = b.bar;
        __builtin_amdgcn_s_waitcnt(0);
        unsigned nloc = b.st[0], nx = b.st[1];
        if (nloc == 0u) { xcd_barrier_complete(bar, b.x, nloc, nx); b.st[0] = nloc; b.st[1] = nx; }
        const unsigned old = xb_add(&bar[XB_XSUB(b.x)], 1u);
        const unsigned gen = old / nloc;
        if (old + 1u == (gen + 1u) * nloc) {
            __builtin_amdgcn_fence(__ATOMIC_RELEASE, "agent");
            asm volatile("s_waitcnt vmcnt(0)" ::: "memory");
            const unsigned og = xb_add(&bar[XB_TOP], 1u);
            const unsigned tg = og / nx;
            if (og + 1u == (tg + 1u) * nx) xb_add(&bar[XB_TOPGEN], 1u);
            else XB_SPIN(xb_ld(&bar[XB_TOPGEN]) == tg, bar);
            __builtin_amdgcn_fence(__ATOMIC_ACQUIRE, "agent");
            xb_add(&bar[XB_XGEN(b.x)], 1u);
            asm volatile("s_waitcnt vmcnt(0)" ::: "memory");
        } else {
            XB_SPIN(xb_ld(&bar[XB_XGEN(b.x)]) == gen, bar);
            __builtin_amdgcn_fence(__ATOMIC_ACQUIRE, "agent");
            asm volatile("s_waitcnt vmcnt(0)" ::: "memory");
        }
    }
    __syncthreads();
}

struct Args { const float* in[28]; float* out; unsigned char* ws; int ph_lo, ph_hi; };

__global__ void __launch_bounds__(512, 2) mega_fwd(Args a) {
    extern __shared__ __attribute__((aligned(16))) unsigned char lds_raw[];
    LAS unsigned char* lds = (LAS unsigned char*)lds_raw;
    const int tid = threadIdx.x, lane = tid & 63, wid = __builtin_amdgcn_readfirstlane(tid >> 6);
    const int G = gridDim.x, bx = blockIdx.x;
    unsigned char* ws = a.ws;
    const int lo = a.ph_lo, hi = a.ph_hi;
#define IN(k) (lo <= (k) && (k) < hi)
#define SYNC_AFTER(k) do { if (IN(k) && IN((k) + 1)) { xcd_barrier(xbar); } } while (0)
    { volatile LAS unsigned* st_ = (volatile LAS unsigned*)(lds + LDS_BYTES - 16); if (tid < 4) st_[tid] = 0u; }
    __syncthreads();
    const XcdBarrier xbar = xcd_barrier_post((unsigned*)(ws + WS_CTL) + 2048, (volatile LAS unsigned*)(lds + LDS_BYTES - 16));
    if (hi > 100) cg::this_grid().sync();
    const float* x = a.in[0];
    bf16_t* H = (bf16_t*)a.out;
    bf16_t* VT = (bf16_t*)((unsigned char*)a.out + 64 * MiB);
    bf16_t* MH = (bf16_t*)(ws + WS_MH);
    float* LOGF = (float*)(ws + WS_LOGF); float* C2 = (float*)(ws + WS_C2); float* SS = (float*)(ws + WS_SS);
    unsigned* CTL = (unsigned*)(ws + WS_CTL);

    if (IN(0)) {
        const int gw = bx * NWAVES + wid, NGW = G * NWAVES;
        LAS float* wl = (LAS float*)lds;
        for (int i = tid; i < 1024 * 8; i += 512) { const int k = i >> 3, g = i & 7; const int j = k >> 8, ln = (k >> 2) & 63, e = k & 3;
            wl[((j * 4 + e) * 64 + ln) * 8 + g] = a.in[3][(size_t)k * INCOLS + 3072 + g]; }
        for (int i = bx * 512 + tid; i < NTOK; i += G * 512) SS[i] = 0.f;
        if (bx == 0 && tid < 64) { float* GN = (float*)(ws + WS_CTL + 4096); const float qs = 0.125f * LOG2E;
            GN[tid] = a.in[5][tid] * qs; GN[64 + tid] = a.in[6][tid]; GN[128 + tid] = a.in[12][tid] * qs; GN[192 + tid] = a.in[13][tid]; }
        __syncthreads();
        LAS float* scr = (LAS float*)(lds + 32768 + wid * 8448);
        constexpr int I0 = 2816, I1 = I0 + 512, I2 = I1 + 256, I3 = I2 + 256, I4 = I3 + 256, I5 = I4 + 256, I6 = I5 + 256, I7 = I6 + 512, I8 = I7 + 2816, I9 = I8 + 1408;
        for (int it = gw; it < I9; it += NGW) {
            if (it < I0) transpose_item(a.in[3], 1024, INCOLS, (bf16_t*)(ws + WS_W1), 176, 0, nullptr, scr, it, lane);
            else if (it < I1) transpose_item(a.in[3], 1024, INCOLS, (bf16_t*)(ws + WS_WV), 32, 1, nullptr, scr, it - I0, lane);
            else if (it < I2) transpose_item(a.in[16], 1024, 1024, (bf16_t*)(ws + WS_WMK), 16, 2, nullptr, scr, it - I1, lane);
            else if (it < I3) transpose_item(a.in[16], 1024, 1024, (bf16_t*)(ws + WS_WMV), 16, 3, nullptr, scr, it - I2, lane);
            else if (it < I4) transpose_item(a.in[19], 512, 1024, (bf16_t*)(ws + WS_WBR), 32, 4, nullptr, scr, it - I3, lane);
            else if (it < I5) transpose_item(a.in[20], 512, 1024, (bf16_t*)(ws + WS_WBR) + 1024 * 512, 32, 4, nullptr, scr, it - I4, lane);
            else if (it < I6) transpose_item(a.in[21], 512, 1024, (bf16_t*)(ws + WS_WBR) + 2 * 1024 * 512, 32, 4, nullptr, scr, it - I5, lane);
            else if (it < I7) transpose_item(a.in[22], 1024, 1024, (bf16_t*)(ws + WS_WOUT), 32, 4, nullptr, scr, it - I6, lane);
            else if (it < I8) transpose_item(a.in[24], 1024, UPN, (bf16_t*)(ws + WS_WUP), 176, 8, a.in[23], scr, it - I7, lane);
            else transpose_item(a.in[27], DFF, 1024, (bf16_t*)(ws + WS_WDN), 32, 4, nullptr, scr, it - I8, lane);
        }
        f32x4 gv[4];
#pragma unroll
        for (int j = 0; j < 4; ++j) gv[j] = ((const f32x4*)a.in[2])[lane + 64 * j];
        const float fbias = a.in[14][lane & 7];
        {
        f32x4 nx[4];
        if (gw < NTOK) { const f32x4* xr = (const f32x4*)(x + (size_t)gw * DM) + lane;
#pragma unroll
            for (int j = 0; j < 4; ++j) nx[j] = xr[64 * j]; }
        for (int m = gw; m < NTOK; m += NGW) {
            f32x4 v[4]; float s = 0.f;
#pragma unroll
            for (int j = 0; j < 4; ++j) v[j] = nx[j];
            if (m + NGW < NTOK) { const f32x4* xr = (const f32x4*)(x + (size_t)(m + NGW) * DM) + lane;
#pragma unroll
                for (int j = 0; j < 4; ++j) nx[j] = xr[64 * j]; }
#pragma unroll
            for (int j = 0; j < 4; ++j) s += (v[j][0] * v[j][0] + v[j][1] * v[j][1]) + (v[j][2] * v[j][2] + v[j][3] * v[j][3]);
            const float rstd = rsqrtf(wave_sum(s) * (1.f / DM) + EPS);
            unsigned long long* o8 = (unsigned long long*)(H + (size_t)m * DM) + lane;
            float fg[8];
#pragma unroll
            for (int g = 0; g < 8; ++g) fg[g] = 0.f;
#pragma unroll
            for (int j = 0; j < 4; ++j) {
                v[j] = v[j] * rstd * gv[j];
                o8[64 * j] = (unsigned long long)cvtpk(v[j][0], v[j][1]) | ((unsigned long long)cvtpk(v[j][2], v[j][3]) << 32);
#pragma unroll
                for (int e = 0; e < 4; ++e) { const LAS f32x4* wp = (const LAS f32x4*)(wl + ((j * 4 + e) * 64 + lane) * 8); const f32x4 w0 = wp[0], w1 = wp[1];
                    fg[0] += v[j][e] * w0[0]; fg[1] += v[j][e] * w0[1]; fg[2] += v[j][e] * w0[2]; fg[3] += v[j][e] * w0[3];
                    fg[4] += v[j][e] * w1[0]; fg[5] += v[j][e] * w1[1]; fg[6] += v[j][e] * w1[2]; fg[7] += v[j][e] * w1[3]; }
            }
            float mine = 0.f;
#pragma unroll
            for (int g = 0; g < 8; ++g) { const float t = wave_sum(fg[g]); if ((lane & 7) == g) mine = t; }
            if (lane < 8) { const float z = mine + fbias; const float lf = fminf(z, 0.f) - log1pf(__expf(-fabsf(z)));
                LOGF[(size_t)((m >> 11) * 8 + lane) * SEQ + (m & 2047)] = lf; }
        }
        }
#pragma unroll
        for (int j = 0; j < 4; ++j) gv[j] = ((const f32x4*)a.in[15])[lane + 64 * j];
        for (int m = gw; m < NMTOK; m += NGW) {
            const f32x4* xr = (const f32x4*)(a.in[1] + (size_t)m * DM) + lane;
            f32x4 v[4]; float s = 0.f;
#pragma unroll
            for (int j = 0; j < 4; ++j) { v[j] = xr[64 * j]; s += (v[j][0] * v[j][0] + v[j][1] * v[j][1]) + (v[j][2] * v[j][2] + v[j][3] * v[j][3]); }
            const float rstd = rsqrtf(wave_sum(s) * (1.f / DM) + EPS);
            unsigned long long* o8 = (unsigned long long*)(MH + (size_t)m * DM) + lane;
#pragma unroll
            for (int j = 0; j < 4; ++j) { v[j] = v[j] * rstd * gv[j]; o8[64 * j] = (unsigned long long)cvtpk(v[j][0], v[j][1]) | ((unsigned long long)cvtpk(v[j][2], v[j][3]) << 32); }
        }
        __syncthreads();
    }
    SYNC_AFTER(0);

    if (IN(1)) {
        if (bx >= G - 16) {
            const int seq = (bx - (G - 16)) * 8 + wid;
            if (seq < NB * 8) {
                const f32x4* src = (const f32x4*)(LOGF + (size_t)seq * SEQ + lane * 32);
                float run = 0.f;
#pragma unroll
                for (int i = 0; i < 8; ++i) { const f32x4 v = src[i]; run += (v[0] + v[1]) + (v[2] + v[3]); }
                float incl = run;
#pragma unroll
                for (int o = 1; o < 64; o <<= 1) { const float t = __shfl_up(incl, o); if (lane >= o) incl += t; }
                float pre = incl - run;
                f32x4* dst = (f32x4*)(C2 + (size_t)seq * SEQ + lane * 32);
#pragma unroll
                for (int i = 0; i < 8; ++i) { f32x4 v = src[i]; v[0] += pre; v[1] += v[0]; v[2] += v[1]; v[3] += v[2]; pre = v[3]; dst[i] = v * LOG2E; }
            }
        }
        { pg8::Gemm g{(const char*)H, (const char*)(ws + WS_W1), 1024, 0, 0, 0}; pg8::Order S; S.init(NTOK, UPN, G, bx, 1);
          EpiProj E{(bf16_t*)(ws + WS_QK), (unsigned char*)(ws + WS_G), (const float*)(ws + WS_CTL + 4096), a.in[4]};
          pg8::gemm_phase<EpiProj>(lds, g, S, E); }
        { pg8::Gemm g{(const char*)(ws + WS_WV), (const char*)H, 1024, 0, 0, 0}; pg8::Order S; S.init(1024, NTOK, G, bx, 1);
          EpiNat E{VT, NTOK};
          pg8::gemm_phase<EpiNat>(lds, g, S, E); }
    }
    SYNC_AFTER(1);

    if (IN(2)) {
        AttnP P{(const bf16_t*)(ws + WS_QK), VT, (const bf16_t*)(ws + WS_MK), (const bf16_t*)(ws + WS_MVT), C2, (bf16_t*)(ws + WS_O), a.out,
                a.in[7], a.in[8], a.in[9], a.in[10], a.in[11], a.in[17], a.in[18], (const float*)(ws + WS_CTL + 4096)};
        LAS int* uw = (LAS int*)(lds + AT_UNITW);
        for (int j = bx; j < 64; j += G) {
            if (j < 32) { pg8::Gemm g{(const char*)MH, (const char*)(ws + WS_WMK), 1024, 0, 0, 0}; pg8::Order S; S.init(NMTOK, 512, 32, j, 1);
                EpiPlain E{(bf16_t*)(ws + WS_MK), 512};
                pg8::gemm_phase<EpiPlain>(lds, g, S, E); }
            else { pg8::Gemm g{(const char*)(ws + WS_WMV), (const char*)MH, 1024, 0, 0, 0}; pg8::Order S; S.init(512, NMTOK, 32, j - 32, 1);
                EpiNat E{(bf16_t*)(ws + WS_MVT), NMTOK};
                pg8::gemm_phase<EpiNat>(lds, g, S, E); }
            asm volatile("s_waitcnt vmcnt(0)" ::: "memory");
            __syncthreads();
            if (tid == 0) { __builtin_amdgcn_fence(__ATOMIC_RELEASE, "agent"); asm volatile("s_waitcnt vmcnt(0)" ::: "memory");
                __hip_atomic_fetch_add(CTL + 128, 1u, __ATOMIC_RELAXED, __HIP_MEMORY_SCOPE_AGENT); }
        }
        bool mem_ready = false;
        int idx = bx;
        if (wid >= 4) __builtin_amdgcn_s_setprio(1);
        for (;;) {
            if (idx >= N_ATT_UNITS) break;
            unsigned nxt = 0u;
            if (tid == 0) nxt = atomicAdd(CTL, 1u);
            int kind, qb, sub; decode_unit(idx, kind, qb, sub);
            if (kind == 0) attn_unit<0>(lds, P, sub >> 2, sub & 3, qb);
            else if (kind == 1) attn_fx64(lds, P, sub >> 3, sub & 7, qb);
            else {
                if (!mem_ready) {
                    if (tid == 0) { while (__hip_atomic_load(CTL + 128, __ATOMIC_RELAXED, __HIP_MEMORY_SCOPE_AGENT) < 64u) __builtin_amdgcn_s_sleep(8);
                        __builtin_amdgcn_fence(__ATOMIC_ACQUIRE, "agent"); asm volatile("s_waitcnt vmcnt(0)" ::: "memory"); }
                    __syncthreads();
                    mem_ready = true;
                }
                attn_unit<2>(lds, P, sub >> 2, sub & 3, qb);
            }
            if (tid == 0) *uw = G + (int)nxt;
            __syncthreads();
            idx = __builtin_amdgcn_readfirstlane(*uw);
            __syncthreads();
        }
        __builtin_amdgcn_s_setprio(0);
    }
    SYNC_AFTER(2);

    if (IN(3)) {
        pg8::Gemm g{(const char*)(ws + WS_O), (const char*)(ws + WS_WBR), 512, 0, (size_t)NTOK * 512 * 2, (size_t)1024 * 512 * 2}; pg8::Order S; S.init(NTOK, DM, G, bx, 3);
        EpiMerge E{(const unsigned char*)(ws + WS_G), (bf16_t*)(ws + WS_MERGED)};
        pg8::gemm_phase<EpiMerge>(lds, g, S, E);
    }
    SYNC_AFTER(3);

    if (IN(4)) {
        pg8::Gemm g{(const char*)(ws + WS_MERGED), (const char*)(ws + WS_WOUT), 1024, 0, 0, 0}; pg8::Order S; S.init(NTOK, DM, G, bx, 1);
        EpiOut E{x, a.out, (bf16_t*)(ws + WS_X1B), SS};
        pg8::gemm_phase<EpiOut>(lds, g, S, E);
    }
    SYNC_AFTER(4);

    if (IN(5)) {
        pg8::Gemm g{(const char*)(ws + WS_X1B), (const char*)(ws + WS_WUP), 1024, 1, 0, 0}; pg8::Order S; S.init(NTOK, UPN, G, bx, 1);
        EpiUp E{SS, a.in[25], a.in[26], (bf16_t*)(ws + WS_ACT), (float*)(ws + WS_UB)};
        pg8::gemm_phase<EpiUp>(lds, g, S, E);
    }
    SYNC_AFTER(5);

    if (IN(6)) {
        pg8::Order S; S.init(NTOK, DM, G, bx, 1);
        const float* UB = (const float*)(ws + WS_UB); bf16_t* ACT = (bf16_t*)(ws + WS_ACT);
        const float* cw = a.in[25]; const float* cb = a.in[26];
        Unit u;
        for (int i = 0; S.next(i, u); ++i) {
            for (int gg = 0; gg < 2; ++gg) {
                const int grp = u.pm * 2 + gg; const bool hasprev = (grp & 15) != 0;
                const float* ub = UB + (size_t)grp * DFF * 8; const float* pb = UB + (size_t)(grp - 1) * DFF * 8 + 4;
                for (int ch = tid; ch < DFF; ch += 512) {
                    const f32x4 uf = *(const f32x4*)(ub + (size_t)ch * 8);
                    const float u0a = uf[0], u0g = uf[1], u1a = uf[2], u1g = uf[3];
                    float p2a = 0.f, p1a = 0.f, p2g = 0.f, p1g = 0.f;
                    if (hasprev) { const f32x4 pf_ = *(const f32x4*)(pb + (size_t)ch * 8); p2a = pf_[0]; p2g = pf_[1]; p1a = pf_[2]; p1g = pf_[3]; }
                    const float wa0 = cw[ch], wa1 = cw[UPN + ch], wa2 = cw[2 * UPN + ch], ba = cb[ch];
                    const float wg0 = cw[DFF + ch], wg1 = cw[UPN + DFF + ch], wg2 = cw[2 * UPN + DFF + ch], bg = cb[DFF + ch];
                    const float ca0 = wa0 * p2a + wa1 * p1a + wa2 * u0a + ba, cg0 = wg0 * p2g + wg1 * p1g + wg2 * u0g + bg;
                    const float ca1 = wa0 * p1a + wa1 * u0a + wa2 * u1a + ba, cg1 = wg0 * p1g + wg1 * u0g + wg2 * u1g + bg;
                    const unsigned w0 = cvtpk(ca0 * sigmoidf_(ca0) * cg0, 0.f), w1 = cvtpk(ca1 * sigmoidf_(ca1) * cg1, 0.f);
                    ACT[(size_t)(grp * 128) * DFF + ch] = (bf16_t)(w0 & 0xffffu);
                    ACT[(size_t)(grp * 128 + 1) * DFF + ch] = (bf16_t)(w1 & 0xffffu);
                }
            }
        }
        asm volatile("s_waitcnt vmcnt(0)" ::: "memory");
        __syncthreads();
        pg8::Gemm g{(const char*)(ws + WS_ACT), (const char*)(ws + WS_WDN), DFF, 0, 0, 0};
        EpiDown E{a.out, (const bf16_t*)(ws + WS_X1B)};
        pg8::gemm_phase<EpiDown>(lds, g, S, E);
    }
#undef IN
#undef SYNC_AFTER
}

extern "C" void kernel_launch(void* const* d_in, const int* in_sizes, int n_in, void* d_out, int out_size, void* d_ws, size_t ws_size, hipStream_t stream) {
    static int grid = 0;
    if (grid == 0) {
        int dev = 0, cus = 0, per_cu = 0;
        if (hipGetDevice(&dev) != hipSuccess || hipDeviceGetAttribute(&cus, hipDeviceAttributeMultiprocessorCount, dev) != hipSuccess) { fprintf(stderr, "kernel_launch: device query failed\n"); grid = -1; return; }
        if (hipFuncSetAttribute((const void*)mega_fwd, hipFuncAttributeMaxDynamicSharedMemorySize, LDS_BYTES) != hipSuccess) { fprintf(stderr, "kernel_launch: hipFuncSetAttribute failed\n"); grid = -1; return; }
        if (hipOccupancyMaxActiveBlocksPerMultiprocessor(&per_cu, (const void*)mega_fwd, 512, LDS_BYTES) != hipSuccess || per_cu < 1) { fprintf(stderr, "kernel_launch: occupancy query says %d\n", per_cu); per_cu = 1; }
        (void)hipGetLastError();
        grid = cus * per_cu;
        if (n_in != 28 || ws_size < 512 * MiB) fprintf(stderr, "kernel_launch: unexpected n_in %d / ws %zu\n", n_in, ws_size);
    }
    if (grid < 0) return;
    Args a{};
    for (int i = 0; i < 28; ++i) a.in[i] = (const float*)d_in[i];
    a.out = (float*)d_out; a.ws = (unsigned char*)d_ws;
#if MK_PER_PHASE
    for (int p = 0; p < 7; ++p) { a.ph_lo = p; a.ph_hi = p + 1; hipLaunchKernelGGL(mega_fwd, dim3(grid), dim3(512), LDS_BYTES, stream, a); }
#else
    (void)hipMemsetAsync(d_ws, 0, 24576, stream);
    a.ph_lo = 0; a.ph_hi = 7;
    void* args[] = {&a};
    hipError_t e = hipLaunchCooperativeKernel((const void*)mega_fwd, dim3(grid), dim3(512), args, LDS_BYTES, stream);
    if (e != hipSuccess) fprintf(stderr, "kernel_launch: cooperative launch failed: %s (grid %d)\n", hipGetErrorString(e), grid);
#endif
}
```

```cpp
#include <hip/hip_runtime.h>
#include <hip/hip_cooperative_groups.h>
#include <cstdio>
#include <cstdint>
namespace cg = cooperative_groups;

#ifndef MK_PER_PHASE
#define MK_PER_PHASE 0
#endif

#define LAS __attribute__((address_space(3)))
typedef unsigned short bf16_t;
typedef short bf16x8 __attribute__((ext_vector_type(8)));
typedef short s16x4 __attribute__((ext_vector_type(4)));
typedef float f32x4 __attribute__((ext_vector_type(4)));
typedef float f32x16 __attribute__((ext_vector_type(16)));
typedef float f32x2 __attribute__((ext_vector_type(2)));
typedef unsigned u32x4 __attribute__((ext_vector_type(4)));
typedef unsigned u32x2 __attribute__((ext_vector_type(2)));
typedef __bf16 bf16x2_t __attribute__((ext_vector_type(2)));

constexpr int DM = 1024, NB = 16, SEQ = 2048, NTOK = NB * SEQ, NMEM = 256, NMTOK = NB * NMEM;
constexpr int INCOLS = 6664, DFF = 2816, UPN = 5632;
constexpr float EPS = 1e-6f, LOG2E = 1.4426950408889634f;
constexpr int QKP = 2560, GP = 3072;
constexpr int NWAVES = 8;
constexpr int LDS_BYTES = 147456;

constexpr size_t MiB = 1u << 20;
constexpr size_t WS_CTL = 0, WS_LOGF = 1 * MiB, WS_C2 = 2 * MiB, WS_SS = 3 * MiB, WS_MK = 4 * MiB, WS_MVT = 8 * MiB;
constexpr size_t WS_W1 = 12 * MiB, WS_WV = 23 * MiB, WS_WMK = 25 * MiB, WS_WMV = 26 * MiB, WS_WBR = 27 * MiB, WS_WOUT = 30 * MiB;
constexpr size_t WS_WUP = 32 * MiB, WS_WDN = 43 * MiB, WS_MH = 56 * MiB;
constexpr size_t WS_QK = 64 * MiB, WS_G = 224 * MiB, WS_O = 416 * MiB;
constexpr size_t WS_MERGED = 64 * MiB, WS_X1B = 128 * MiB, WS_ACT = 224 * MiB, WS_UB = 400 * MiB;

__device__ __forceinline__ unsigned cvtpk(float lo, float hi) { f32x2 v = {lo, hi}; bf16x2_t b = __builtin_convertvector(v, bf16x2_t); return __builtin_bit_cast(unsigned, b); }
__device__ __forceinline__ float bf2f(unsigned short b) { return __uint_as_float((unsigned)b << 16); }
__device__ __forceinline__ float bflo(unsigned w) { return __uint_as_float(w << 16); }
__device__ __forceinline__ float bfhi(unsigned w) { return __uint_as_float(w & 0xffff0000u); }
__device__ __forceinline__ float dpp_shr1(float v) { return __int_as_float(__builtin_amdgcn_update_dpp(0, __float_as_int(v), 0x111  , 0xf, 0xf, false)); }
__device__ __forceinline__ float wave_sum(float v) {
    v += __int_as_float(__builtin_amdgcn_update_dpp(0, __float_as_int(v), 0xB1, 0xf, 0xf, false));
    v += __int_as_float(__builtin_amdgcn_update_dpp(0, __float_as_int(v), 0x4E, 0xf, 0xf, false));
    v += __int_as_float(__builtin_amdgcn_update_dpp(0, __float_as_int(v), 0x141, 0xf, 0xf, false));
    v += __int_as_float(__builtin_amdgcn_update_dpp(0, __float_as_int(v), 0x140, 0xf, 0xf, false));
    v += __int_as_float(__builtin_amdgcn_update_dpp(0, __float_as_int(v), 0x142, 0xa, 0xf, false));
    v += __int_as_float(__builtin_amdgcn_update_dpp(0, __float_as_int(v), 0x143, 0xc, 0xf, false));
    return __int_as_float(__builtin_amdgcn_readlane(__float_as_int(v), 63));
}
__device__ __forceinline__ float sum_fq(float v) {
    { const auto r = __builtin_amdgcn_permlane16_swap(__float_as_uint(v), __float_as_uint(v), false, false); v = __uint_as_float(r[0]) + __uint_as_float(r[1]); }
    { const auto r = __builtin_amdgcn_permlane32_swap(__float_as_uint(v), __float_as_uint(v), false, false); v = __uint_as_float(r[0]) + __uint_as_float(r[1]); }
    return v;
}
__device__ __forceinline__ float row16_sum(float v) {
    v += __int_as_float(__builtin_amdgcn_update_dpp(0, __float_as_int(v), 0xB1, 0xf, 0xf, false));
    v += __int_as_float(__builtin_amdgcn_update_dpp(0, __float_as_int(v), 0x4E, 0xf, 0xf, false));
    v += __int_as_float(__builtin_amdgcn_update_dpp(0, __float_as_int(v), 0x141, 0xf, 0xf, false));
    v += __int_as_float(__builtin_amdgcn_update_dpp(0, __float_as_int(v), 0x140, 0xf, 0xf, false));
    return v;
}
__device__ __forceinline__ float fast_exp2(float x) { return __builtin_amdgcn_exp2f(x); }
__device__ __forceinline__ float fast_rcp(float x) { return __builtin_amdgcn_rcpf(x); }
__device__ __forceinline__ float sigmoidf_(float z) { return fast_rcp(1.f + fast_exp2(-z * LOG2E)); }

namespace pg8 {
constexpr int BM = 256, BK = 64, HALF = 128, HTB = HALF * BK * 2, STAGE_BYTES = 8 * HTB, NXCD = 8, WGM = 8;
__host__ __device__ __forceinline__ int lds_byte(int r, int c) { const int st = (r >> 4) * 2 + (c >> 5), rr = r & 15, cc = c & 31, ob = rr * 64 + cc * 2; return st * 1024 + (ob ^ (((ob >> 9) & 1) << 5)); }
__host__ __device__ __forceinline__ void stage_rc(int b, int& R, int& C) { const int st = b / 1024, sb = b % 1024, swz = sb ^ (((sb >> 9) & 1) << 5); R = (st >> 1) * 16 + swz / 64; C = (st & 1) * 32 + (swz % 64) / 2; }

struct Unit { int pm, pn, seg; };
struct Gemm { const char* A; const char* Bt; int K; int a_perm; size_t a_seg, b_seg; };

struct Order {
    int nM, nN, nwg, G, c, nseg;
    __device__ void init(int M, int N, int G_, int c_, int nseg_) { nM = M / BM; nN = N / BM; nwg = nM * nN; G = G_; c = c_; nseg = nseg_; }
    __device__ bool next(int i, Unit& u) const {
        const int seg = i % nseg, ii = i / nseg;
        const long L = (long)ii * G + c; if (L >= nwg) return false;
        int wgid = (int)L; { const int q = nwg / NXCD, r = nwg % NXCD, xcd = wgid % NXCD, off = wgid / NXCD; wgid = (xcd < r ? xcd * (q + 1) : r * (q + 1) + (xcd - r) * q) + off; }
        const int nig = WGM * nN, gid = wgid / nig, fm = gid * WGM, gsz = (nM - fm) < WGM ? (nM - fm) : WGM;
        u.pm = fm + ((wgid % nig) % gsz); u.pn = (wgid % nig) / gsz; u.seg = seg; return true;
    }
};

template <class Epi>
__device__ __forceinline__ void gemm_phase(LAS unsigned char* lds, const Gemm g, const Order& S, const Epi& E) {
    const int tid = threadIdx.x, wid = __builtin_amdgcn_readfirstlane(tid >> 6), lane = tid & 63, wr = wid >> 2, wc = wid & 3, fr = lane & 15, fq = lane >> 4;
    const int K = g.K, nt = K / BK;
    unsigned voffA[2], voffB[2];
#pragma unroll
    for (int i = 0; i < 2; ++i) { int R, C; stage_rc(tid * 16 + i * 8192, R, C);
        const int Ra = g.a_perm ? (8 * (16 * (R >> 6) + (R & 15)) + ((R >> 4) & 3)) : R;
        voffA[i] = (unsigned)(Ra * K + C) * 2u; voffB[i] = (unsigned)(R * K + C) * 2u; }
    const size_t kstep = (size_t)(BK * 2);
    const size_t hstep = (size_t)HALF * K * 2;
    const size_t hstepA = g.a_perm ? (size_t)4 * K * 2 : hstep;
    const size_t tstep = 2 * hstep;
    const unsigned ldsw = (unsigned)wid * 1024u;
    const int aoff = lds_byte(wr * 64 + fr, fq * 8), boff = lds_byte(wc * 32 + fr, fq * 8);
#define PG8_SA(b, h) (((b) * 2 + (h)) * HTB)
#define PG8_SB(b, h) ((4 + (b) * 2 + (h)) * HTB)
#define PG8_STAGE(bufoff, gbase, voff) do { _Pragma("unroll") for (int _i = 0; _i < 2; ++_i) \
        __builtin_amdgcn_global_load_lds((const unsigned*)((const char*)(gbase) + (voff)[_i]), (LAS unsigned*)(lds + (bufoff) + ldsw + _i * 8192), 16, 0, 0); } while (0)
#define PG8_LDA(dst, b, h) do { _Pragma("unroll") for (int m = 0; m < 4; ++m) _Pragma("unroll") for (int k = 0; k < 2; ++k) dst[m][k] = *(const LAS bf16x8*)(lds + PG8_SA(b, h) + aoff + m * 2048 + k * 1024); } while (0)
#define PG8_LDB(dst, b, h) do { _Pragma("unroll") for (int n = 0; n < 2; ++n) _Pragma("unroll") for (int k = 0; k < 2; ++k) dst[n][k] = *(const LAS bf16x8*)(lds + PG8_SB(b, h) + boff + n * 2048 + k * 1024); } while (0)
#define PG8_MMA(ai, bj, At, Bt) do { __builtin_amdgcn_s_setprio(1); _Pragma("unroll") for (int m = 0; m < 4; ++m) _Pragma("unroll") for (int n = 0; n < 2; ++n) _Pragma("unroll") for (int k = 0; k < 2; ++k) \
        acc[ai][bj][m][n] = __builtin_amdgcn_mfma_f32_16x16x32_bf16(Bt[n][k], At[m][k], acc[ai][bj][m][n], 0, 0, 0); __builtin_amdgcn_s_setprio(0); } while (0)
#define PG8_WAIT_V(n) asm volatile("s_waitcnt vmcnt(" #n ")" ::: "memory")
#define PG8_WAIT_L(n) asm volatile("s_waitcnt lgkmcnt(" #n ")" ::: "memory")
#define PG8_BAR __builtin_amdgcn_s_barrier()
#define PG8_SCHED __builtin_amdgcn_sched_barrier(0)
    Unit cur, nxt; int ui = 0;
    if (!S.next(0, cur)) return;
    f32x4 acc[2][2][4][2];
#pragma unroll
    for (int a = 0; a < 2; ++a)
#pragma unroll
        for (int b = 0; b < 2; ++b)
#pragma unroll
            for (int m = 0; m < 4; ++m)
#pragma unroll
                for (int n = 0; n < 2; ++n) acc[a][b][m][n] = (f32x4){0.f, 0.f, 0.f, 0.f};
    bf16x8 At[4][2], B0[2][2], B1[2][2];
    const char* cA = g.A + (size_t)cur.pm * tstep + (size_t)cur.seg * g.a_seg; const char* cB = g.Bt + (size_t)cur.pn * tstep + (size_t)cur.seg * g.b_seg;
    PG8_STAGE(PG8_SB(0, 0), cB, voffB); PG8_STAGE(PG8_SB(0, 1), cB + hstep, voffB); PG8_STAGE(PG8_SA(0, 0), cA, voffA); PG8_STAGE(PG8_SA(0, 1), cA + hstepA, voffA);
    if (wr == 1) PG8_BAR;
    PG8_WAIT_V(2); PG8_BAR;
    PG8_STAGE(PG8_SB(1, 0), cB + kstep, voffB); PG8_STAGE(PG8_SA(1, 0), cA + kstep, voffA); PG8_STAGE(PG8_SB(1, 1), cB + hstep + kstep, voffB);
    PG8_WAIT_V(6); PG8_BAR;
    for (;;) {
        const bool has_next = S.next(ui + 1, nxt);
        const char* nA = has_next ? g.A + (size_t)nxt.pm * tstep + (size_t)nxt.seg * g.a_seg : cA; const char* nB = has_next ? g.Bt + (size_t)nxt.pn * tstep + (size_t)nxt.seg * g.b_seg : cB;
        for (int t = 0; t < nt; t += 2) {
            const bool last = (t == nt - 2);
            const char* a1 = cA + (size_t)(t + 1) * kstep;
            const char* a2 = last ? nA : cA + (size_t)(t + 2) * kstep; const char* b2 = last ? nB : cB + (size_t)(t + 2) * kstep;
            const char* a3 = a2 + kstep; const char* b3 = b2 + kstep;
            PG8_LDB(B0, 0, 0); PG8_LDB(B1, 0, 1); PG8_SCHED; PG8_LDA(At, 0, 0); PG8_STAGE(PG8_SA(1, 1), a1 + hstepA, voffA);
            PG8_WAIT_V(8); PG8_WAIT_L(0); PG8_BAR; PG8_MMA(0, 0, At, B0); PG8_MMA(0, 1, At, B1); PG8_BAR; PG8_SCHED;
            PG8_LDA(At, 0, 1); PG8_STAGE(PG8_SB(0, 0), b2, voffB); PG8_STAGE(PG8_SB(0, 1), b2 + hstep, voffB); PG8_STAGE(PG8_SA(0, 0), a2, voffA);
            PG8_WAIT_V(8); PG8_WAIT_L(0); PG8_BAR; PG8_MMA(1, 0, At, B0); PG8_MMA(1, 1, At, B1); PG8_BAR; PG8_SCHED;
            PG8_LDB(B0, 1, 0); PG8_LDB(B1, 1, 1); PG8_SCHED; PG8_LDA(At, 1, 0); PG8_STAGE(PG8_SA(0, 1), a2 + hstepA, voffA);
            PG8_WAIT_V(8); PG8_WAIT_L(0); PG8_BAR; PG8_MMA(0, 0, At, B0); PG8_MMA(0, 1, At, B1); PG8_BAR; PG8_SCHED;
            PG8_LDA(At, 1, 1); PG8_STAGE(PG8_SB(1, 0), b3, voffB); PG8_STAGE(PG8_SB(1, 1), b3 + hstep, voffB); PG8_STAGE(PG8_SA(1, 0), a3, voffA);
            PG8_WAIT_V(8); PG8_WAIT_L(0); PG8_BAR; PG8_MMA(1, 0, At, B0); PG8_MMA(1, 1, At, B1); PG8_BAR; PG8_SCHED;
        }
        if (wr == 0) PG8_BAR;
        E(acc, cur, wr, wc, fr, fq);
        if (!has_next) break;
        if (E.reset_after(cur))
#pragma unroll
        for (int a = 0; a < 2; ++a)
#pragma unroll
            for (int b = 0; b < 2; ++b)
#pragma unroll
                for (int m = 0; m < 4; ++m)
#pragma unroll
                    for (int n = 0; n < 2; ++n) acc[a][b][m][n] = (f32x4){0.f, 0.f, 0.f, 0.f};
        cur = nxt; cA = nA; cB = nB; ++ui;
        if (wr == 1) PG8_BAR;
    }
    PG8_WAIT_V(0);
    PG8_BAR;
#undef PG8_SA
#undef PG8_SB
#undef PG8_STAGE
#undef PG8_LDA
#undef PG8_LDB
#undef PG8_MMA
#undef PG8_WAIT_V
#undef PG8_WAIT_L
#undef PG8_BAR
#undef PG8_SCHED
}
}
using pg8::Unit;
typedef f32x4 Acc[2][2][4][2];

__device__ __forceinline__ int perm16(int c) { return ((c >> 5) & 3) * 64 + ((c >> 2) & 3) * 16 + (c >> 7) * 8 + ((c >> 4) & 1) * 4 + (c & 3); }

struct EpiProj {
    __device__ __forceinline__ bool reset_after(const Unit&) const { return true; }
    bf16_t* QK; unsigned char* G; const float* GN; const float* b_gate;
    __device__ __forceinline__ void operator()(const Acc& acc, const Unit& u, int wr, int wc, int fr, int fq) const {
        const int row0 = u.pm * 256 + wr * 64 + fr, lcol = wc * 64 + fq * 16;
        if (u.pn < 10) {
            const int kind = u.pn >> 1;
            bf16_t* base = QK + (size_t)row0 * QKP + u.pn * 256 + lcol;
            if (kind < 4) {
                const float* gp = GN + kind * 64 + fq * 16;
                const f32x4 gn0 = *(const f32x4*)(gp), gn1 = *(const f32x4*)(gp + 4), gn2 = *(const f32x4*)(gp + 8), gn3 = *(const f32x4*)(gp + 12);
#pragma unroll
                for (int ai = 0; ai < 2; ++ai)
#pragma unroll
                    for (int m = 0; m < 4; ++m) {
                        float ss = 0.f;
#pragma unroll
                        for (int bj = 0; bj < 2; ++bj)
#pragma unroll
                            for (int n = 0; n < 2; ++n) { const f32x4 v = acc[ai][bj][m][n]; ss += (v[0] * v[0] + v[1] * v[1]) + (v[2] * v[2] + v[3] * v[3]); }
                        ss = sum_fq(ss);
                        const float rs = rsqrtf(ss * (1.f / 64.f) + EPS);
                        bf16_t* rowp = base + (size_t)(ai * 128 + m * 16) * QKP;
#pragma unroll
                        for (int bj = 0; bj < 2; ++bj) {
                            const f32x4 v0 = acc[ai][bj][m][0] * rs * (bj ? gn2 : gn0), v1 = acc[ai][bj][m][1] * rs * (bj ? gn3 : gn1);
                            u32x4 w; w.x = cvtpk(v0[0], v0[1]); w.y = cvtpk(v0[2], v0[3]); w.z = cvtpk(v1[0], v1[1]); w.w = cvtpk(v1[2], v1[3]);
                            *(u32x4*)(rowp + 8 * bj) = w; }
                    }
            } else {
#pragma unroll
                for (int ai = 0; ai < 2; ++ai)
#pragma unroll
                    for (int m = 0; m < 4; ++m) {
                        bf16_t* rowp = base + (size_t)(ai * 128 + m * 16) * QKP;
#pragma unroll
                        for (int bj = 0; bj < 2; ++bj) {
                            const f32x4 v0 = acc[ai][bj][m][0], v1 = acc[ai][bj][m][1];
                            u32x4 w; w.x = cvtpk(v0[0], v0[1]); w.y = cvtpk(v0[2], v0[3]); w.z = cvtpk(v1[0], v1[1]); w.w = cvtpk(v1[2], v1[3]);
                            *(u32x4*)(rowp + 8 * bj) = w; }
                    }
            }
        } else {
            const int col = (u.pn - 10) * 256 + lcol;
            unsigned char* base = G + (size_t)row0 * GP + col;
            const f32x4 bv0 = *(const f32x4*)(b_gate + col), bv1 = *(const f32x4*)(b_gate + col + 4), bv2 = *(const f32x4*)(b_gate + col + 8), bv3 = *(const f32x4*)(b_gate + col + 12);
#pragma unroll
            for (int ai = 0; ai < 2; ++ai)
#pragma unroll
                for (int m = 0; m < 4; ++m) {
                    u32x4 w;
#pragma unroll
                    for (int bj = 0; bj < 2; ++bj)
#pragma unroll
                        for (int n = 0; n < 2; ++n) {
                            const f32x4 v = acc[ai][bj][m][n] + (bj ? (n ? bv3 : bv2) : (n ? bv1 : bv0));
                            const unsigned q0 = (unsigned)(sigmoidf_(v[0]) * 255.f + 0.5f), q1 = (unsigned)(sigmoidf_(v[1]) * 255.f + 0.5f), q2 = (unsigned)(sigmoidf_(v[2]) * 255.f + 0.5f), q3 = (unsigned)(sigmoidf_(v[3]) * 255.f + 0.5f);
                            w[2 * bj + n] = q0 | (q1 << 8) | (q2 << 16) | (q3 << 24);
                        }
                    *(u32x4*)(base + (size_t)(ai * 128 + m * 16) * GP) = w;
                }
        }
    }
};
struct EpiNat {
    __device__ __forceinline__ bool reset_after(const Unit&) const { return true; }
    bf16_t* O; int ldc;
    __device__ __forceinline__ void operator()(const Acc& acc, const Unit& u, int wr, int wc, int fr, int fq) const {
        bf16_t* base = O + (size_t)(u.pm * 256 + wr * 64 + fr) * ldc + u.pn * 256 + wc * 32 + fq * 4;
#pragma unroll
        for (int ai = 0; ai < 2; ++ai)
#pragma unroll
            for (int m = 0; m < 4; ++m) {
                bf16_t* rowp = base + (size_t)(ai * 128 + m * 16) * ldc;
#pragma unroll
                for (int bj = 0; bj < 2; ++bj)
#pragma unroll
                    for (int n = 0; n < 2; ++n) { const f32x4 v = acc[ai][bj][m][n]; u32x2 w; w.x = cvtpk(v[0], v[1]); w.y = cvtpk(v[2], v[3]); *(u32x2*)(rowp + bj * 128 + n * 16) = w; }
            }
    }
};
struct EpiPlain {
    __device__ __forceinline__ bool reset_after(const Unit&) const { return true; }
    bf16_t* O; int ldc;
    __device__ __forceinline__ void operator()(const Acc& acc, const Unit& u, int wr, int wc, int fr, int fq) const {
        bf16_t* base = O + (size_t)(u.pm * 256 + wr * 64 + fr) * ldc + u.pn * 256 + wc * 64 + fq * 16;
#pragma unroll
        for (int ai = 0; ai < 2; ++ai)
#pragma unroll
            for (int m = 0; m < 4; ++m) {
                bf16_t* rowp = base + (size_t)(ai * 128 + m * 16) * ldc;
#pragma unroll
                for (int bj = 0; bj < 2; ++bj) {
                    const f32x4 v0 = acc[ai][bj][m][0], v1 = acc[ai][bj][m][1];
                    u32x4 w; w.x = cvtpk(v0[0], v0[1]); w.y = cvtpk(v0[2], v0[3]); w.z = cvtpk(v1[0], v1[1]); w.w = cvtpk(v1[2], v1[3]);
                    *(u32x4*)(rowp + 8 * bj) = w; }
            }
    }
};
__device__ __forceinline__ f32x4 gate4(unsigned w) { f32x4 g; g[0] = (float)(w & 0xffu); g[1] = (float)((w >> 8) & 0xffu); g[2] = (float)((w >> 16) & 0xffu); g[3] = (float)(w >> 24);
    g[0] = fmaxf(g[0], 1e-3f); g[1] = fmaxf(g[1], 1e-3f); g[2] = fmaxf(g[2], 1e-3f); g[3] = fmaxf(g[3], 1e-3f); return g; }
struct EpiMerge {
    __device__ __forceinline__ bool reset_after(const Unit& u) const { return u.seg == 2; }
    const unsigned char* G; bf16_t* MERGED;
    __device__ __forceinline__ void operator()(Acc& acc, const Unit& u, int wr, int wc, int fr, int fq) const {
        const int row0 = u.pm * 256 + wr * 64 + fr, col = u.pn * 256 + wc * 64 + fq * 16;
        const unsigned char* gbase = G + (size_t)row0 * GP + u.seg * 1024 + col;
        u32x4 gn[8], gd[8];
#pragma unroll
        for (int i = 0; i < 8; ++i) gn[i] = *(const u32x4*)(gbase + (size_t)((i >> 2) * 128 + (i & 3) * 16) * GP);
        if (u.seg < 2) {
#pragma unroll
            for (int i = 0; i < 8; ++i) gd[i] = *(const u32x4*)(gbase + (size_t)((i >> 2) * 128 + (i & 3) * 16) * GP + 1024);
        }
        asm volatile("" ::: "memory");
#pragma unroll
        for (int ai = 0; ai < 2; ++ai)
#pragma unroll
            for (int m = 0; m < 4; ++m) {
                const size_t row = (size_t)(row0 + ai * 128 + m * 16);
                const u32x4 gnw = gn[ai * 4 + m];
                if (u.seg < 2) {
                    const u32x4 gdw = gd[ai * 4 + m];
#pragma unroll
                    for (int bj = 0; bj < 2; ++bj)
#pragma unroll
                        for (int n = 0; n < 2; ++n) { const f32x4 a_ = gate4(gnw[2 * bj + n]), d_ = gate4(gdw[2 * bj + n]); f32x4 r;
                            r[0] = a_[0] * fast_rcp(d_[0]); r[1] = a_[1] * fast_rcp(d_[1]); r[2] = a_[2] * fast_rcp(d_[2]); r[3] = a_[3] * fast_rcp(d_[3]);
                            acc[ai][bj][m][n] *= r; }
                } else {
                    bf16_t* mp = MERGED + row * DM + col;
#pragma unroll
                    for (int bj = 0; bj < 2; ++bj) {
                        const f32x4 v0 = acc[ai][bj][m][0] * gate4(gnw[2 * bj]) * (1.f / 255.f), v1 = acc[ai][bj][m][1] * gate4(gnw[2 * bj + 1]) * (1.f / 255.f);
                        u32x4 w; w.x = cvtpk(v0[0], v0[1]); w.y = cvtpk(v0[2], v0[3]); w.z = cvtpk(v1[0], v1[1]); w.w = cvtpk(v1[2], v1[3]);
                        *(u32x4*)(mp + 8 * bj) = w; }
                }
            }
    }
};
struct EpiOut {
    __device__ __forceinline__ bool reset_after(const Unit&) const { return true; }
    const float* X; float* OUT; bf16_t* X1B; float* SS;
    __device__ __forceinline__ void operator()(const Acc& acc, const Unit& u, int wr, int wc, int fr, int fq) const {
        const int row0 = u.pm * 256 + wr * 64 + fr, col = u.pn * 256 + wc * 64 + fq * 16;
        f32x4 xv[4][4];
#pragma unroll
        for (int i = 0; i < 4; ++i) { const float* xp = X + (size_t)(row0 + i * 16) * DM + col;
#pragma unroll
            for (int q = 0; q < 4; ++q) xv[i][q] = *(const f32x4*)(xp + 4 * q); }
        asm volatile("" ::: "memory");
#pragma unroll
        for (int i = 0; i < 8; ++i) {
            const int ai = i >> 2, m = i & 3;
            const size_t row = (size_t)(row0 + ai * 128 + m * 16);
            float ss = 0.f;
#pragma unroll
            for (int bj = 0; bj < 2; ++bj) {
                const f32x4 v0 = acc[ai][bj][m][0] + xv[i & 3][2 * bj], v1 = acc[ai][bj][m][1] + xv[i & 3][2 * bj + 1];
                ss += (v0[0] * v0[0] + v0[1] * v0[1]) + (v0[2] * v0[2] + v0[3] * v0[3]) + (v1[0] * v1[0] + v1[1] * v1[1]) + (v1[2] * v1[2] + v1[3] * v1[3]);
                u32x4 w; w.x = cvtpk(v0[0], v0[1]); w.y = cvtpk(v0[2], v0[3]); w.z = cvtpk(v1[0], v1[1]); w.w = cvtpk(v1[2], v1[3]);
                *(u32x4*)(X1B + row * DM + col + 8 * bj) = w;
            }
            if (i < 4) { const float* xp = X + (size_t)(row0 + 128 + i * 16) * DM + col;
#pragma unroll
                for (int q = 0; q < 4; ++q) xv[i][q] = *(const f32x4*)(xp + 4 * q); }
            ss = sum_fq(ss);
            if (fq == 0) atomicAdd(SS + row, ss);
        }
    }
};
struct EpiUp {
    __device__ __forceinline__ bool reset_after(const Unit&) const { return true; }
    const float* SS; const float* cw; const float* cb; bf16_t* ACT; float* UB;
    __device__ __forceinline__ void operator()(const Acc& acc, const Unit& u, int wr, int wc, int fr, int fq) const {
        const int T0 = u.pm * 256 + wr * 128 + fr * 8, grp = u.pm * 2 + wr, ch0 = u.pn * 128 + wc * 32 + fq * 8;
        const f32x4 sA = *(const f32x4*)(SS + T0), sB = *(const f32x4*)(SS + T0 + 4);
        const float r0 = rsqrtf(sA[0] * (1.f / 1024.f) + EPS), r1 = rsqrtf(sA[1] * (1.f / 1024.f) + EPS), r2 = rsqrtf(sA[2] * (1.f / 1024.f) + EPS), r3 = rsqrtf(sA[3] * (1.f / 1024.f) + EPS);
        const float r4 = rsqrtf(sB[0] * (1.f / 1024.f) + EPS), r5 = rsqrtf(sB[1] * (1.f / 1024.f) + EPS), r6 = rsqrtf(sB[2] * (1.f / 1024.f) + EPS), r7 = rsqrtf(sB[3] * (1.f / 1024.f) + EPS);
        bf16_t* actp = ACT + (size_t)T0 * DFF + ch0;
        float* ubp = UB + ((size_t)grp * DFF + ch0) * 8 + (fr == 15 ? 4 : 0);
#pragma unroll
        for (int n = 0; n < 2; ++n) {
            f32x4 cwa[3], cwg[3];
#pragma unroll
            for (int k = 0; k < 3; ++k) { cwa[k] = *(const f32x4*)(cw + k * UPN + ch0 + 4 * n); cwg[k] = *(const f32x4*)(cw + k * UPN + DFF + ch0 + 4 * n); }
            const f32x4 cba = *(const f32x4*)(cb + ch0 + 4 * n), cbg = *(const f32x4*)(cb + DFF + ch0 + 4 * n);
            unsigned pk[8][2];
#pragma unroll
            for (int jp = 0; jp < 2; ++jp) {
                float res[2][8];
#pragma unroll
                for (int jj = 0; jj < 2; ++jj) {
                    const int j = 2 * jp + jj;
                    const f32x2 w0 = (f32x2){cwa[0][j], cwg[0][j]}, w1 = (f32x2){cwa[1][j], cwg[1][j]}, w2 = (f32x2){cwa[2][j], cwg[2][j]}, bb = (f32x2){cba[j], cbg[j]};
                    const f32x2 x0 = (f32x2){acc[0][0][0][n][j], acc[0][1][0][n][j]} * r0, x1 = (f32x2){acc[0][0][1][n][j], acc[0][1][1][n][j]} * r1;
                    const f32x2 x2 = (f32x2){acc[0][0][2][n][j], acc[0][1][2][n][j]} * r2, x3 = (f32x2){acc[0][0][3][n][j], acc[0][1][3][n][j]} * r3;
                    const f32x2 x4 = (f32x2){acc[1][0][0][n][j], acc[1][1][0][n][j]} * r4, x5 = (f32x2){acc[1][0][1][n][j], acc[1][1][1][n][j]} * r5;
                    const f32x2 x6 = (f32x2){acc[1][0][2][n][j], acc[1][1][2][n][j]} * r6, x7 = (f32x2){acc[1][0][3][n][j], acc[1][1][3][n][j]} * r7;
                    const f32x2 xm2 = (f32x2){dpp_shr1(x6[0]), dpp_shr1(x6[1])}, xm1 = (f32x2){dpp_shr1(x7[0]), dpp_shr1(x7[1])};
                    if (fr == 0) *(f32x4*)(ubp + (4 * n + j) * 8) = (f32x4){x0[0], x0[1], x1[0], x1[1]};
                    if (fr == 15) *(f32x4*)(ubp + (4 * n + j) * 8) = (f32x4){x6[0], x6[1], x7[0], x7[1]};
#define UPC(r, p2, p1, p0) do { const f32x2 c_ = w0 * (p2) + (w1 * (p1) + (w2 * (p0) + bb)); res[jj][r] = c_[0] * sigmoidf_(c_[0]) * c_[1]; } while (0)
                    UPC(0, xm2, xm1, x0); UPC(1, xm1, x0, x1); UPC(2, x0, x1, x2); UPC(3, x1, x2, x3);
                    UPC(4, x2, x3, x4); UPC(5, x3, x4, x5); UPC(6, x4, x5, x6); UPC(7, x5, x6, x7);
#undef UPC
                }
#pragma unroll
                for (int r = 0; r < 8; ++r) pk[r][jp] = cvtpk(res[0][r], res[1][r]);
            }
#pragma unroll
            for (int r = 0; r < 8; ++r) {
                if (fr == 0 && r < 2) continue;
                *(u32x2*)(actp + (size_t)r * DFF + 4 * n) = (u32x2){pk[r][0], pk[r][1]};
            }
        }
    }
};
struct EpiDown {
    __device__ __forceinline__ bool reset_after(const Unit&) const { return true; }
    float* OUT; const bf16_t* X1B;
    __device__ __forceinline__ void operator()(const Acc& acc, const Unit& u, int wr, int wc, int fr, int fq) const {
        const int row0 = u.pm * 256 + wr * 64 + fr, col = u.pn * 256 + wc * 64 + fq * 16;
        u32x4 t[8][2];
#pragma unroll
        for (int i = 0; i < 8; ++i) { const size_t off = (size_t)(row0 + (i >> 2) * 128 + (i & 3) * 16) * DM + col; t[i][0] = *(const u32x4*)(X1B + off); t[i][1] = *(const u32x4*)(X1B + off + 8); }
        asm volatile("" ::: "memory");
#pragma unroll
        for (int ai = 0; ai < 2; ++ai)
#pragma unroll
            for (int m = 0; m < 4; ++m) {
                const size_t off = (size_t)(row0 + ai * 128 + m * 16) * DM + col;
                float* op = OUT + off;
#pragma unroll
                for (int bj = 0; bj < 2; ++bj) {
                    const u32x4 tw = t[ai * 4 + m][bj];
                    f32x4 v0 = acc[ai][bj][m][0], v1 = acc[ai][bj][m][1];
                    v0[0] += bflo(tw.x); v0[1] += bfhi(tw.x); v0[2] += bflo(tw.y); v0[3] += bfhi(tw.y);
                    v1[0] += bflo(tw.z); v1[1] += bfhi(tw.z); v1[2] += bflo(tw.w); v1[3] += bfhi(tw.w);
                    *(f32x4*)(op + 8 * bj) = v0; *(f32x4*)(op + 8 * bj + 4) = v1; }
            }
    }
};

struct AttnP {
    const bf16_t* QK; const bf16_t* VT; const bf16_t* MK; const bf16_t* MVT; const float* C2; bf16_t* O; float* S0;
    const float* lq1; const float* lk1; const float* lq2; const float* lk2; const float* subln; const float* mqn; const float* mkn; const float* GN;
};
__device__ __forceinline__ float max3f_(float a, float b, float c) { float r; asm("v_max3_f32 %0, %1, %2, %3" : "=v"(r) : "v"(a), "v"(b), "v"(c)); return r; }
constexpr int AT_KOFF = 0, AT_VOFF = 17408, AT_COFF = 35840, AT_BUF = 36096, AT_UNITW = 3 * AT_BUF;

template <int KIND>
__device__ __forceinline__ void attn_unit(LAS unsigned char* lds, const AttnP& P, int b, int head, int qb) {
    constexpr int DK = KIND == 2 ? 128 : 64, DV = KIND == 1 ? 64 : 128, NST = DK / 16, NDB = DV / 32;
    constexpr int KPITCH = DK * 2 + 16, VPITCH = 144;
    constexpr int NPASS = KIND == 0 ? 2 : 1;
    constexpr int KLD = DK / 64, VLD = DV / 64;
    int tid = threadIdx.x; asm volatile("" : "+v"(tid));
    const int lane = tid & 63, wid = __builtin_amdgcn_readfirstlane(tid >> 6), r32 = lane & 31, h = lane >> 5;
    const int q0 = qb * 256, qrow = q0 + wid * 32 + r32;
    const size_t tok0 = (size_t)b * SEQ;
    const int nkt = KIND == 2 ? 4 : (q0 + 256) / 64;
    const int wlast = KIND == 2 ? 3 : (q0 + wid * 32) / 64;
    float lam = 0.f;
    if (KIND == 0) {
        float v1 = P.lq1[lane] * P.lk1[lane], v2 = P.lq2[lane] * P.lk2[lane];
        v1 = wave_sum(v1); v2 = wave_sum(v2);
        lam = __expf(v1) - __expf(v2) + 0.2f;
    }
    const float sl2 = KIND == 0 ? LOG2E * exp2f(-2.f * (float)(head + 1)) : 0.f;
    int nit = nkt;
    if (KIND == 0) {
        float gq = fabsf(P.GN[lane]), gk = fabsf(P.GN[64 + lane]);
#pragma unroll
        for (int o = 1; o < 64; o <<= 1) { gq = fmaxf(gq, __shfl_xor(gq, o)); gk = fmaxf(gk, __shfl_xor(gk, o)); }
        const float B = 1.03f * 64.f * gq * gk;
        const float dmax = (B + 150.f) / sl2;
        int ktm = (int)ceilf(((float)(q0 - 63) - dmax) * (1.f / 64.f));
        ktm = ktm < 0 ? 0 : ktm;
        nit = __builtin_amdgcn_readfirstlane(nkt - ktm);
        if (nit < 1) nit = 1;
    }
#pragma unroll 1
    for (int pass = 0; pass < NPASS; ++pass) {
        const bf16_t *Qp, *Kp, *VTp; int kpitch, vtpitch;
        if (KIND == 0) { Qp = P.QK + tok0 * QKP + head * 128 + pass * 64; Kp = P.QK + tok0 * QKP + 512 + head * 128 + pass * 64; kpitch = QKP; VTp = P.VT + (size_t)(head * 128) * NTOK + tok0; vtpitch = NTOK; }
        else if (KIND == 1) { Qp = P.QK + tok0 * QKP + 1024 + head * 64; Kp = P.QK + tok0 * QKP + 1536 + head * 64; kpitch = QKP; VTp = P.VT + (size_t)(512 + head * 64) * NTOK + tok0; vtpitch = NTOK; }
        else { Qp = P.QK + tok0 * QKP + 2048 + head * 128; Kp = P.MK + (size_t)(b * NMEM) * 512 + head * 128; kpitch = 512; VTp = P.MVT + (size_t)(head * 128) * NMTOK + b * NMEM; vtpitch = NMTOK; }
        bf16x8 qf[NST];
#pragma unroll
        for (int st = 0; st < NST; ++st) qf[st] = *(const bf16x8*)(Qp + (size_t)qrow * QKP + 16 * st + 8 * h);
        if (KIND == 2) {
            float ss = 0.f;
#pragma unroll
            for (int st = 0; st < NST; ++st)
#pragma unroll
                for (int j = 0; j < 8; ++j) { const float v = bf2f((unsigned short)qf[st][j]); ss += v * v; }
            ss += __shfl_xor(ss, 32);
            const float rs = rsqrtf(ss * (1.f / 128.f) + EPS) * (0.08838834764831845f * LOG2E);
#pragma unroll
            for (int st = 0; st < NST; ++st) {
                const f32x4 g0 = *(const f32x4*)(P.mqn + 16 * st + 8 * h), g1 = *(const f32x4*)(P.mqn + 16 * st + 8 * h + 4);
                u32x4 w;
                w.x = cvtpk(bf2f((unsigned short)qf[st][0]) * rs * g0[0], bf2f((unsigned short)qf[st][1]) * rs * g0[1]);
                w.y = cvtpk(bf2f((unsigned short)qf[st][2]) * rs * g0[2], bf2f((unsigned short)qf[st][3]) * rs * g0[3]);
                w.z = cvtpk(bf2f((unsigned short)qf[st][4]) * rs * g1[0], bf2f((unsigned short)qf[st][5]) * rs * g1[1]);
                w.w = cvtpk(bf2f((unsigned short)qf[st][6]) * rs * g1[2], bf2f((unsigned short)qf[st][7]) * rs * g1[3]);
                qf[st] = __builtin_bit_cast(bf16x8, w);
            }
        }
        float m_ref = 0.f, l_run = 0.f;
        f32x16 oT[NDB];
#pragma unroll
        for (int db = 0; db < NDB; ++db)
#pragma unroll
            for (int r = 0; r < 16; ++r) oT[db][r] = 0.f;
        u32x4 kreg[KLD], vreg[VLD]; float creg = 0.f;
#define AT_LOAD(kt) do { const int k0_ = (kt) * 64; \
        _Pragma("unroll") for (int i = 0; i < KLD; ++i) { const int idx = tid + 512 * i, row = idx / (DK / 8), chn = idx % (DK / 8); kreg[i] = *(const u32x4*)(Kp + (size_t)(k0_ + row) * kpitch + chn * 8); } \
        _Pragma("unroll") for (int i = 0; i < VLD; ++i) { const int idx = tid + 512 * i, row = idx >> 3, chn = idx & 7; vreg[i] = *(const u32x4*)(VTp + (size_t)row * vtpitch + k0_ + chn * 8); } \
        if (KIND == 1 && tid < 64) creg = P.C2[(size_t)(b * 8 + head) * SEQ + k0_ + tid]; } while (0)
#define AT_STORE(bufi) do { LAS unsigned char* bb = lds + (bufi) * AT_BUF; \
        _Pragma("unroll") for (int i = 0; i < KLD; ++i) { const int idx = tid + 512 * i, row = idx / (DK / 8), chn = idx % (DK / 8); u32x4 kv = kreg[i]; \
            if (KIND == 2) { float f[8]; f[0] = bflo(kv.x); f[1] = bfhi(kv.x); f[2] = bflo(kv.y); f[3] = bfhi(kv.y); f[4] = bflo(kv.z); f[5] = bfhi(kv.z); f[6] = bflo(kv.w); f[7] = bfhi(kv.w); \
                float ss = 0.f; _Pragma("unroll") for (int e = 0; e < 8; ++e) ss += f[e] * f[e]; \
                ss = row16_sum(ss); \
                const float rs = rsqrtf(ss * (1.f / 128.f) + EPS); const f32x4 g0 = *(const f32x4*)(P.mkn + chn * 8), g1 = *(const f32x4*)(P.mkn + chn * 8 + 4); \
                kv.x = cvtpk(f[0] * rs * g0[0], f[1] * rs * g0[1]); kv.y = cvtpk(f[2] * rs * g0[2], f[3] * rs * g0[3]); kv.z = cvtpk(f[4] * rs * g1[0], f[5] * rs * g1[1]); kv.w = cvtpk(f[6] * rs * g1[2], f[7] * rs * g1[3]); } \
            *(LAS u32x4*)(bb + AT_KOFF + row * KPITCH + chn * 16) = kv; } \
        _Pragma("unroll") for (int i = 0; i < VLD; ++i) { const int idx = tid + 512 * i, row = idx >> 3, chn = idx & 7; LAS unsigned char* vp_ = bb + AT_VOFF + row * VPITCH + (chn >> 1) * 32 + (chn & 1) * 8; \
            *(LAS u32x2*)vp_ = (u32x2){vreg[i].x, vreg[i].y}; *(LAS u32x2*)(vp_ + 16) = (u32x2){vreg[i].z, vreg[i].w}; } \
        if (KIND == 1 && tid < 64) *(LAS float*)(bb + AT_COFF + tid * 4) = creg; } while (0)
        AT_LOAD(nkt - 1); AT_STORE(0);
        __syncthreads();
#define AT_PV(bufp) do { const LAS unsigned char* vb_ = (bufp) + AT_VOFF + r32 * VPITCH + h * 16; \
        _Pragma("unroll") for (int dp = 0; dp < NDB / 2; ++dp) { bf16x8 va[2][4]; \
            _Pragma("unroll") for (int d2 = 0; d2 < 2; ++d2) _Pragma("unroll") for (int kk = 0; kk < 4; ++kk) va[d2][kk] = *(const LAS bf16x8*)(vb_ + (2 * dp + d2) * 32 * VPITCH + kk * 32); \
            __builtin_amdgcn_sched_barrier(0); \
            _Pragma("unroll") for (int kk = 0; kk < 4; ++kk) _Pragma("unroll") for (int d2 = 0; d2 < 2; ++d2) oT[2 * dp + d2] = __builtin_amdgcn_mfma_f32_32x32x16_bf16(va[d2][kk], pf[kk], oT[2 * dp + d2], 0, 0, 0); \
            __builtin_amdgcn_sched_barrier(0); } } while (0)
        const bool lateB = false;
        bool have_prev = false; int prev_buf = 0, bi = 0;
        bf16x8 pf[4];
#pragma unroll
        for (int i = 0; i < 4; ++i) pf[i] = (bf16x8){0, 0, 0, 0, 0, 0, 0, 0};
#pragma unroll 1
        for (int it = 0; it < nit; ++it) {
            const int kt = nkt - 1 - it;
            if (it + 1 < nit) AT_LOAD(kt - 1);
            if (lateB && have_prev) { AT_PV(lds + prev_buf * AT_BUF); }
            if (kt <= wlast) {
                const LAS unsigned char* buf = lds + bi * AT_BUF;
                const int k0 = kt * 64;
                f32x16 s0, s1;
                if (KIND == 0 && kt < wlast) {
                    const float nb = -m_ref - sl2 * (float)(qrow - k0 - 4 * h);
#pragma unroll
                    for (int r = 0; r < 16; ++r) { const float o = (float)((r & 3) + 8 * (r >> 2)); s0[r] = fmaf(sl2, o, nb); s1[r] = fmaf(sl2, o + 32.f, nb); }
                } else if (KIND == 1) {
                    const LAS float* cs = (const LAS float*)(buf + AT_COFF);
#pragma unroll
                    for (int g = 0; g < 4; ++g) { const f32x4 c0 = *(const LAS f32x4*)(cs + 8 * g + 4 * h), c1 = *(const LAS f32x4*)(cs + 32 + 8 * g + 4 * h);
#pragma unroll
                        for (int i = 0; i < 4; ++i) { s0[4 * g + i] = -m_ref - c0[i]; s1[4 * g + i] = -m_ref - c1[i]; } }
                } else {
#pragma unroll
                    for (int r = 0; r < 16; ++r) { s0[r] = -m_ref; s1[r] = -m_ref; }
                }
                const LAS unsigned char* kb_ = buf + AT_KOFF + r32 * KPITCH + h * 16;
#pragma unroll
                for (int sg = 0; sg < NST / 4; ++sg) {
                    bf16x8 ka[4][2];
#pragma unroll
                    for (int st = 0; st < 4; ++st) { ka[st][0] = *(const LAS bf16x8*)(kb_ + (4 * sg + st) * 32); ka[st][1] = *(const LAS bf16x8*)(kb_ + 32 * KPITCH + (4 * sg + st) * 32); }
                    __builtin_amdgcn_sched_barrier(0);
#pragma unroll
                    for (int st = 0; st < 4; ++st) {
                        s0 = __builtin_amdgcn_mfma_f32_32x32x16_bf16(ka[st][0], qf[4 * sg + st], s0, 0, 0, 0);
                        s1 = __builtin_amdgcn_mfma_f32_32x32x16_bf16(ka[st][1], qf[4 * sg + st], s1, 0, 0, 0);
                    }
                    __builtin_amdgcn_sched_barrier(0);
                }
                if (KIND == 1) {
                    if (kt == wlast) {
#pragma unroll
                        for (int r = 0; r < 16; ++r) { const int kv = k0 + (r & 3) + 8 * (r >> 2) + 4 * h; if (kv > qrow) s0[r] = -INFINITY; if (kv + 32 > qrow) s1[r] = -INFINITY; }
                    }
                }
                if (KIND == 0 && kt == wlast) {
                    const float dq = (float)(qrow - k0 - 4 * h);
#pragma unroll
                    for (int r = 0; r < 16; ++r) { const float o = (float)((r & 3) + 8 * (r >> 2)); s0[r] = fmaf(-sl2, fabsf(dq - o), s0[r]); s1[r] = fmaf(-sl2, fabsf(dq - o - 32.f), s1[r]); }
                }
                float mx = max3f_(s0[0], s1[0], s0[1]), mxb = max3f_(s1[1], s0[2], s1[2]);
#pragma unroll
                for (int r = 3; r < 15; r += 2) { mx = max3f_(mx, s0[r], s1[r]); mxb = max3f_(mxb, s0[r + 1], s1[r + 1]); }
                mx = max3f_(mx, s0[15], s1[15]); mx = max3f_(mx, mxb, mxb);
                { const auto rr = __builtin_amdgcn_permlane32_swap(__float_as_uint(mx), __float_as_uint(mx), false, false); mx = max3f_(__uint_as_float(rr[0]), __uint_as_float(rr[1]), __uint_as_float(rr[1])); }
                if (!(KIND == 0 && __all(mx < -150.f))) {
                if (__any(mx > 8.f)) {
                    const float dl = fmaxf(mx, 0.f), f = fast_exp2(-dl);
                    m_ref += dl; l_run *= f;
#pragma unroll
                    for (int r = 0; r < 16; ++r) { s0[r] -= dl; s1[r] -= dl; }
#pragma unroll
                    for (int db = 0; db < NDB; ++db)
#pragma unroll
                        for (int r = 0; r < 16; ++r) oT[db][r] *= f;
                }
                const LAS unsigned char* vb0_ = buf + AT_VOFF + r32 * VPITCH + h * 16;
                bf16x8 va0[2][4];
#pragma unroll
                for (int d2 = 0; d2 < 2; ++d2)
#pragma unroll
                    for (int kk = 0; kk < 4; ++kk) va0[d2][kk] = *(const LAS bf16x8*)(vb0_ + d2 * 32 * VPITCH + kk * 32);
                __builtin_amdgcn_sched_barrier(0);
                f32x2 rs2 = (f32x2){0.f, 0.f};
#pragma unroll
                for (int r = 0; r < 16; ++r) { s0[r] = fast_exp2(s0[r]); s1[r] = fast_exp2(s1[r]); }
#pragma unroll
                for (int r = 0; r < 16; r += 2) { rs2 += (f32x2){s0[r], s0[r + 1]}; rs2 += (f32x2){s1[r], s1[r + 1]}; }
                l_run += rs2[0] + rs2[1];
                { u32x4 w;
                  w.x = cvtpk(s0[0], s0[1]); w.y = cvtpk(s0[2], s0[3]); w.z = cvtpk(s0[4], s0[5]); w.w = cvtpk(s0[6], s0[7]); pf[0] = __builtin_bit_cast(bf16x8, w);
                  w.x = cvtpk(s0[8], s0[9]); w.y = cvtpk(s0[10], s0[11]); w.z = cvtpk(s0[12], s0[13]); w.w = cvtpk(s0[14], s0[15]); pf[1] = __builtin_bit_cast(bf16x8, w);
                  w.x = cvtpk(s1[0], s1[1]); w.y = cvtpk(s1[2], s1[3]); w.z = cvtpk(s1[4], s1[5]); w.w = cvtpk(s1[6], s1[7]); pf[2] = __builtin_bit_cast(bf16x8, w);
                  w.x = cvtpk(s1[8], s1[9]); w.y = cvtpk(s1[10], s1[11]); w.z = cvtpk(s1[12], s1[13]); w.w = cvtpk(s1[14], s1[15]); pf[3] = __builtin_bit_cast(bf16x8, w); }
                __builtin_amdgcn_sched_barrier(0);
#pragma unroll
                for (int kk = 0; kk < 4; ++kk)
#pragma unroll
                    for (int d2 = 0; d2 < 2; ++d2) oT[d2] = __builtin_amdgcn_mfma_f32_32x32x16_bf16(va0[d2][kk], pf[kk], oT[d2], 0, 0, 0);
                __builtin_amdgcn_sched_barrier(0);
                if (NDB == 4) {
                    bf16x8 va1[2][4];
#pragma unroll
                    for (int d2 = 0; d2 < 2; ++d2)
#pragma unroll
                        for (int kk = 0; kk < 4; ++kk) va1[d2][kk] = *(const LAS bf16x8*)(vb0_ + (2 + d2) * 32 * VPITCH + kk * 32);
                    __builtin_amdgcn_sched_barrier(0);
#pragma unroll
                    for (int kk = 0; kk < 4; ++kk)
#pragma unroll
                        for (int d2 = 0; d2 < 2; ++d2) oT[NDB - 2 + d2] = __builtin_amdgcn_mfma_f32_32x32x16_bf16(va1[d2][kk], pf[kk], oT[NDB - 2 + d2], 0, 0, 0);
                    __builtin_amdgcn_sched_barrier(0);
                }
                }
            }
            if (lateB) { have_prev = (kt <= wlast); prev_buf = bi; }
            const int bn = bi == 2 ? 0 : bi + 1;
            if (it + 1 < nit) AT_STORE(bn);
            bi = bn;
            __syncthreads();
        }
        if (lateB && have_prev) { AT_PV(lds + prev_buf * AT_BUF); }
        __syncthreads();
#undef AT_PV
#undef AT_LOAD
#undef AT_STORE
        const float l = l_run + __shfl_xor(l_run, 32), inv = 1.f / l;
        float* sp = P.S0 + (tok0 + qrow) * 512 + head * 128 + 4 * h;
        if (KIND == 0 && pass == 0) {
#pragma unroll
            for (int db = 0; db < NDB; ++db)
#pragma unroll
                for (int g = 0; g < 4; ++g) { f32x4 v; v[0] = oT[db][4 * g] * inv; v[1] = oT[db][4 * g + 1] * inv; v[2] = oT[db][4 * g + 2] * inv; v[3] = oT[db][4 * g + 3] * inv; *(f32x4*)(sp + 32 * db + 8 * g) = v; }
        } else {
            float rs = inv;
            if (KIND == 0) {
                float ss = 0.f; const float li = lam * inv;
#pragma unroll
                for (int db = 0; db < NDB; ++db)
#pragma unroll
                    for (int g = 0; g < 4; ++g) { const f32x4 o0 = *(const f32x4*)(sp + 32 * db + 8 * g);
#pragma unroll
                        for (int i = 0; i < 4; ++i) { const float v = o0[i] - li * oT[db][4 * g + i]; oT[db][4 * g + i] = v; ss += v * v; } }
                ss += __shfl_xor(ss, 32);
                rs = rsqrtf(ss * (1.f / 128.f) + EPS) * 0.8f;
            }
            const int obase = KIND == 0 ? 0 : (KIND == 1 ? 1 : 2);
            bf16_t* op = P.O + (size_t)obase * NTOK * 512 + (tok0 + qrow) * 512 + head * DV + 4 * h;
#pragma unroll
            for (int db = 0; db < NDB; ++db)
#pragma unroll
                for (int g = 0; g < 4; ++g) {
                    f32x4 mu = (f32x4){rs, rs, rs, rs};
                    if (KIND == 0) mu = mu * *(const f32x4*)(P.subln + 32 * db + 8 * g + 4 * h);
                    u32x2 w; w.x = cvtpk(oT[db][4 * g] * mu[0], oT[db][4 * g + 1] * mu[1]); w.y = cvtpk(oT[db][4 * g + 2] * mu[2], oT[db][4 * g + 3] * mu[3]);
                    *(u32x2*)(op + 32 * db + 8 * g) = w; }
        }
    }
}

__device__ __forceinline__ void attn_fx64(LAS unsigned char* lds, const AttnP& P, int b, int head, int qb) {
    constexpr int KPITCH = 144, VPITCH = 144;
    int tid = threadIdx.x; asm volatile("" : "+v"(tid));
    const int lane = tid & 63, wid = __builtin_amdgcn_readfirstlane(tid >> 6), r32 = lane & 31, h = lane >> 5;
    const int q0 = qb * 512, qA = q0 + wid * 64 + r32, qB = qA + 32;
    const size_t tok0 = (size_t)b * SEQ;
    const int nkt = (q0 + 512) / 64, wlast = (q0 >> 6) + wid;
    const bf16_t* Qp = P.QK + tok0 * QKP + 1024 + head * 64;
    const bf16_t* Kp = P.QK + tok0 * QKP + 1536 + head * 64;
    const bf16_t* VTp = P.VT + (size_t)(512 + head * 64) * NTOK + tok0;
    const float* C2p = P.C2 + (size_t)(b * 8 + head) * SEQ;
    bf16x8 qfA[4], qfB[4];
#pragma unroll
    for (int st = 0; st < 4; ++st) { qfA[st] = *(const bf16x8*)(Qp + (size_t)qA * QKP + 16 * st + 8 * h); qfB[st] = *(const bf16x8*)(Qp + (size_t)qB * QKP + 16 * st + 8 * h); }
    float mA = 0.f, mB = 0.f, lA = 0.f, lB = 0.f;
    f32x16 oA[2], oB[2];
#pragma unroll
    for (int d = 0; d < 2; ++d)
#pragma unroll
        for (int r = 0; r < 16; ++r) { oA[d][r] = 0.f; oB[d][r] = 0.f; }
    u32x4 kreg, vreg; float creg = 0.f;
    const int srow = tid >> 3, schn = tid & 7;
#define FX_LOAD(kt) do { const int k0_ = (kt) * 64; kreg = *(const u32x4*)(Kp + (size_t)(k0_ + srow) * QKP + schn * 8); vreg = *(const u32x4*)(VTp + (size_t)srow * NTOK + k0_ + schn * 8); \
        if (tid < 64) creg = C2p[k0_ + tid]; } while (0)
#define FX_STORE(bufi) do { LAS unsigned char* bb = lds + (bufi) * AT_BUF; *(LAS u32x4*)(bb + AT_KOFF + srow * KPITCH + schn * 16) = kreg; \
        LAS unsigned char* vp_ = bb + AT_VOFF + srow * VPITCH + (schn >> 1) * 32 + (schn & 1) * 8; *(LAS u32x2*)vp_ = (u32x2){vreg.x, vreg.y}; *(LAS u32x2*)(vp_ + 16) = (u32x2){vreg.z, vreg.w}; \
        if (tid < 64) *(LAS float*)(bb + AT_COFF + tid * 4) = creg; } while (0)
#define FX_MAX(MX, S0, S1) do { float m_ = max3f_(S0[0], S1[0], S0[1]), n_ = max3f_(S1[1], S0[2], S1[2]); \
        _Pragma("unroll") for (int r = 3; r < 15; r += 2) { m_ = max3f_(m_, S0[r], S1[r]); n_ = max3f_(n_, S0[r + 1], S1[r + 1]); } \
        m_ = max3f_(m_, S0[15], S1[15]); m_ = max3f_(m_, n_, n_); \
        const auto rr_ = __builtin_amdgcn_permlane32_swap(__float_as_uint(m_), __float_as_uint(m_), false, false); MX = max3f_(__uint_as_float(rr_[0]), __uint_as_float(rr_[1]), __uint_as_float(rr_[1])); } while (0)
#define FX_EXP(S0, S1, L, PF) do { f32x2 rs2 = (f32x2){0.f, 0.f}; \
        _Pragma("unroll") for (int r = 0; r < 16; ++r) { S0[r] = fast_exp2(S0[r]); S1[r] = fast_exp2(S1[r]); } \
        _Pragma("unroll") for (int r = 0; r < 16; r += 2) { rs2 += (f32x2){S0[r], S0[r + 1]}; rs2 += (f32x2){S1[r], S1[r + 1]}; } \
        L += rs2[0] + rs2[1]; u32x4 w; \
        w.x = cvtpk(S0[0], S0[1]); w.y = cvtpk(S0[2], S0[3]); w.z = cvtpk(S0[4], S0[5]); w.w = cvtpk(S0[6], S0[7]); PF[0] = __builtin_bit_cast(bf16x8, w); \
        w.x = cvtpk(S0[8], S0[9]); w.y = cvtpk(S0[10], S0[11]); w.z = cvtpk(S0[12], S0[13]); w.w = cvtpk(S0[14], S0[15]); PF[1] = __builtin_bit_cast(bf16x8, w); \
        w.x = cvtpk(S1[0], S1[1]); w.y = cvtpk(S1[2], S1[3]); w.z = cvtpk(S1[4], S1[5]); w.w = cvtpk(S1[6], S1[7]); PF[2] = __builtin_bit_cast(bf16x8, w); \
        w.x = cvtpk(S1[8], S1[9]); w.y = cvtpk(S1[10], S1[11]); w.z = cvtpk(S1[12], S1[13]); w.w = cvtpk(S1[14], S1[15]); PF[3] = __builtin_bit_cast(bf16x8, w); } while (0)
    FX_LOAD(nkt - 1); FX_STORE(0);
    __syncthreads();
#pragma unroll 1
    for (int it = 0; it < nkt; ++it) {
        const int kt = nkt - 1 - it;
        if (it + 1 < nkt) FX_LOAD(kt - 1);
        if (kt <= wlast) {
            const LAS unsigned char* buf = lds + (it & 1) * AT_BUF;
            const int k0 = kt * 64;
            f32x16 a0, a1, b0, b1;
            {
                const LAS float* cs = (const LAS float*)(buf + AT_COFF);
#pragma unroll
                for (int g = 0; g < 4; ++g) { const f32x4 c0 = *(const LAS f32x4*)(cs + 8 * g + 4 * h), c1 = *(const LAS f32x4*)(cs + 32 + 8 * g + 4 * h);
#pragma unroll
                    for (int i = 0; i < 4; ++i) { a0[4 * g + i] = -mA - c0[i]; a1[4 * g + i] = -mA - c1[i]; b0[4 * g + i] = -mB - c0[i]; b1[4 * g + i] = -mB - c1[i]; } }
            }
            {
                const LAS unsigned char* kb_ = buf + AT_KOFF + r32 * KPITCH + h * 16;
                bf16x8 ka[4][2];
#pragma unroll
                for (int st = 0; st < 4; ++st) { ka[st][0] = *(const LAS bf16x8*)(kb_ + st * 32); ka[st][1] = *(const LAS bf16x8*)(kb_ + 32 * KPITCH + st * 32); }
                __builtin_amdgcn_sched_barrier(0);
#pragma unroll
                for (int st = 0; st < 4; ++st) {
                    a0 = __builtin_amdgcn_mfma_f32_32x32x16_bf16(ka[st][0], qfA[st], a0, 0, 0, 0);
                    b0 = __builtin_amdgcn_mfma_f32_32x32x16_bf16(ka[st][0], qfB[st], b0, 0, 0, 0);
                    a1 = __builtin_amdgcn_mfma_f32_32x32x16_bf16(ka[st][1], qfA[st], a1, 0, 0, 0);
                    b1 = __builtin_amdgcn_mfma_f32_32x32x16_bf16(ka[st][1], qfB[st], b1, 0, 0, 0);
                }
                __builtin_amdgcn_sched_barrier(0);
            }
            if (kt == wlast) {
#pragma unroll
                for (int r = 0; r < 16; ++r) { const int kv = k0 + (r & 3) + 8 * (r >> 2) + 4 * h;
                    if (kv > qA) a0[r] = -INFINITY; if (kv + 32 > qA) a1[r] = -INFINITY; if (kv > qB) b0[r] = -INFINITY; if (kv + 32 > qB) b1[r] = -INFINITY; }
            }
            float mxA, mxB; FX_MAX(mxA, a0, a1); FX_MAX(mxB, b0, b1);
            if (!__all(fmaxf(mxA, mxB) < -150.f)) {
            if (__any(fmaxf(mxA, mxB) > 8.f)) {
                const float dA = fmaxf(mxA, 0.f), dB = fmaxf(mxB, 0.f), fA = fast_exp2(-dA), fB = fast_exp2(-dB);
                mA += dA; mB += dB; lA *= fA; lB *= fB;
#pragma unroll
                for (int r = 0; r < 16; ++r) { a0[r] -= dA; a1[r] -= dA; b0[r] -= dB; b1[r] -= dB; }
#pragma unroll
                for (int d = 0; d < 2; ++d)
#pragma unroll
                    for (int r = 0; r < 16; ++r) { oA[d][r] *= fA; oB[d][r] *= fB; }
            }
            const LAS unsigned char* vb_ = buf + AT_VOFF + r32 * VPITCH + h * 16;
            bf16x8 va[2][4];
#pragma unroll
            for (int d2 = 0; d2 < 2; ++d2)
#pragma unroll
                for (int kk = 0; kk < 4; ++kk) va[d2][kk] = *(const LAS bf16x8*)(vb_ + d2 * 32 * VPITCH + kk * 32);
            __builtin_amdgcn_sched_barrier(0);
            bf16x8 pA[4], pB[4];
            FX_EXP(a0, a1, lA, pA);
            __builtin_amdgcn_sched_barrier(0);
#pragma unroll
            for (int kk = 0; kk < 4; ++kk)
#pragma unroll
                for (int d2 = 0; d2 < 2; ++d2) oA[d2] = __builtin_amdgcn_mfma_f32_32x32x16_bf16(va[d2][kk], pA[kk], oA[d2], 0, 0, 0);
            __builtin_amdgcn_sched_barrier(0);
            FX_EXP(b0, b1, lB, pB);
            __builtin_amdgcn_sched_barrier(0);
#pragma unroll
            for (int kk = 0; kk < 4; ++kk)
#pragma unroll
                for (int d2 = 0; d2 < 2; ++d2) oB[d2] = __builtin_amdgcn_mfma_f32_32x32x16_bf16(va[d2][kk], pB[kk], oB[d2], 0, 0, 0);
            __builtin_amdgcn_sched_barrier(0);
            }
        }
        if (it + 1 < nkt) FX_STORE((it + 1) & 1);
        __syncthreads();
    }
#undef FX_LOAD
#undef FX_STORE
#undef FX_MAX
#undef FX_EXP
    const float iA = 1.f / (lA + __shfl_xor(lA, 32)), iB = 1.f / (lB + __shfl_xor(lB, 32));
    bf16_t* opA = P.O + (size_t)NTOK * 512 + (tok0 + qA) * 512 + head * 64 + 4 * h;
    bf16_t* opB = opA + (size_t)32 * 512;
#pragma unroll
    for (int db = 0; db < 2; ++db)
#pragma unroll
        for (int g = 0; g < 4; ++g) {
            u32x2 w; w.x = cvtpk(oA[db][4 * g] * iA, oA[db][4 * g + 1] * iA); w.y = cvtpk(oA[db][4 * g + 2] * iA, oA[db][4 * g + 3] * iA); *(u32x2*)(opA + 32 * db + 8 * g) = w;
            u32x2 x; x.x = cvtpk(oB[db][4 * g] * iB, oB[db][4 * g + 1] * iB); x.y = cvtpk(oB[db][4 * g + 2] * iB, oB[db][4 * g + 3] * iB); *(u32x2*)(opB + 32 * db + 8 * g) = x; }
}

__device__ __forceinline__ void decode_unit(int idx, int& kind, int& qb, int& sub) {
    if (idx < 320) { kind = 0; qb = 7 - idx / 64; sub = idx % 64; }
    else if (idx < 448) { kind = 1; qb = 3; sub = idx - 320; }
    else if (idx < 512) { kind = 0; qb = 2; sub = idx - 448; }
    else if (idx < 640) { kind = 1; qb = 2; sub = idx - 512; }
    else if (idx < 704) { kind = 0; qb = 1; sub = idx - 640; }
    else if (idx < 832) { kind = 1; qb = 1; sub = idx - 704; }
    else if (idx < 896) { kind = 0; qb = 0; sub = idx - 832; }
    else if (idx < 1024) { kind = 1; qb = 0; sub = idx - 896; }
    else { kind = 2; const int t = idx - 1024; qb = t / 64; sub = t % 64; }
}
constexpr int N_ATT_UNITS = 1536;

__device__ __forceinline__ int inv_perm16(int L) { return ((L >> 3) & 1) * 128 + (L >> 6) * 32 + ((L >> 2) & 1) * 16 + ((L >> 4) & 3) * 4 + (L & 3); }
__device__ __forceinline__ int src_of(int mat, int lg) {
    switch (mat) {
    case 0: if (lg < 1024) return lg; if (lg < 2048) return 1536 + (lg - 1024); if (lg < 2560) return 3080 + (lg - 2048); return 3592 + (lg - 2560);
    case 1: return lg < 512 ? 1024 + lg : 2560 + (lg - 512);
    case 3: return 512 + lg;
    default: return lg;
    }
}
__device__ __forceinline__ int dst_of(int mat, int lg) {
    switch (mat) {
    case 1: case 3: return lg;
    case 8: { const int bj = lg >= DFF ? 1 : 0, chl = lg - bj * DFF, pn = chl >> 7, co = chl & 127;
              return pn * 256 + bj * 128 + (co >> 5) * 32 + ((co >> 2) & 1) * 16 + ((co >> 3) & 3) * 4 + (co & 3); }
    default: return (lg & ~255) + inv_perm16(lg & 255);
    }
}
__device__ __forceinline__ void transpose_item(const float* W, int K, int Npitch, bf16_t* WT, int nblk, int mat, const float* rowgain, LAS float* scr, int item, int lane) {
    const int kb = item / nblk, nb = item % nblk, k0 = 64 * kb, l0 = 32 * nb;
    const int sc = src_of(mat, l0 + (lane & 31));
    float t[32];
#pragma unroll
    for (int i = 0; i < 32; ++i) t[i] = W[(size_t)(k0 + 2 * i + (lane >> 5)) * Npitch + sc];
#pragma unroll
    for (int i = 0; i < 32; ++i) { const int kk = 2 * i + (lane >> 5); float v = t[i]; if (rowgain) v *= rowgain[k0 + kk]; scr[kk * 33 + (lane & 31)] = v; }
    asm volatile("s_waitcnt lgkmcnt(0)" ::: "memory");
    const int c = lane & 7;
#pragma unroll
    for (int j = 0; j < 4; ++j) { const int n = (lane >> 3) + 8 * j; const LAS float* sp = scr + (8 * c) * 33 + n;
        u32x4 o; o.x = cvtpk(sp[0 * 33], sp[1 * 33]); o.y = cvtpk(sp[2 * 33], sp[3 * 33]); o.z = cvtpk(sp[4 * 33], sp[5 * 33]); o.w = cvtpk(sp[6 * 33], sp[7 * 33]);
        *(u32x4*)(WT + (size_t)dst_of(mat, l0 + n) * K + k0 + 8 * c) = o; }
    asm volatile("s_waitcnt lgkmcnt(0)" ::: "memory");
}

#define XB_TMO      128
#define XB_XCNT(j)  (256  + 64 * (j))
#define XB_XSUB(j)  (1280 + 64 * (j))
#define XB_XGEN(j)  (2304 + 64 * (j))
#define XB_TOP      3328
#define XB_TOPGEN   3392
#define XCD_BAR_WORDS 3456
#define XB_SPIN_CAP (1u << 22)
__device__ __forceinline__ unsigned xb_ld(unsigned* p)              { return __hip_atomic_load(p, __ATOMIC_RELAXED, __HIP_MEMORY_SCOPE_AGENT); }
__device__ __forceinline__ unsigned xb_add(unsigned* p, unsigned v) { return __hip_atomic_fetch_add(p, v, __ATOMIC_RELAXED, __HIP_MEMORY_SCOPE_AGENT); }
__device__ __forceinline__ unsigned xb_xcc_id() { return (unsigned)__builtin_amdgcn_s_getreg((3 << 11) | 20) & 0xFu; }
#define XB_SPIN(cond, bar) do { unsigned _sp = 0; while (cond) { __builtin_amdgcn_s_sleep(1); \
    if ((++_sp & 255u) == 0u) { if (xb_ld(&(bar)[XB_TMO])) break; if (_sp > XB_SPIN_CAP) { atomicAdd(&(bar)[XB_TMO], 1u); break; } } } } while (0)
struct XcdBarrier { unsigned* bar; unsigned x; volatile LAS unsigned* st; };
__device__ __forceinline__ XcdBarrier xcd_barrier_post(unsigned* bar, volatile LAS unsigned* st) {
    XcdBarrier b; b.bar = bar; b.x = xb_xcc_id(); b.st = st;
    if (threadIdx.x == 0) (void)xb_add(&bar[XB_XCNT(b.x)], 1u);
    return b;
}
__device__ __forceinline__ void xcd_barrier_complete(unsigned* bar, unsigned x, unsigned& nloc, unsigned& nx) {
    const unsigned G = gridDim.x * gridDim.y * gridDim.z;
    unsigned sum, cnt, mine, sp = 0u;
    for (;;) {
        sum = 0u; cnt = 0u; mine = 0u;
#pragma unroll
        for (unsigned j = 0; j < 16; ++j) { const unsigned c = xb_ld(&bar[XB_XCNT(j)]); sum += c; cnt += (c > 0u) ? 1u : 0u; mine = (j == x) ? c : mine; }
        if (sum == G) break;
        __builtin_amdgcn_s_sleep(1);
        if ((++sp & 255u) == 0u) { if (xb_ld(&bar[XB_TMO])) break; if (sp > XB_SPIN_CAP) { atomicAdd(&bar[XB_TMO], 1u); break; } }
    }
    nloc = mine > 0u ? mine : 1u; nx = cnt > 0u ? cnt : 1u;
}
__device__ __forceinline__ void xcd_barrier(const XcdBarrier& b) {
    asm volatile("s_waitcnt vmcnt(0)" ::: "memory");
    __syncthreads();
    if (threadIdx.x == 0) {
        unsigned* bar = b.bar;
        __builtin_amdgcn_s_waitcnt(0);
        unsigned nloc = b.st[0], nx = b.st[1];
        if (nloc == 0u) { xcd_barrier_complete(bar, b.x, nloc, nx); b.st[0] = nloc; b.st[1] = nx; }
        const unsigned old = xb_add(&bar[XB_XSUB(b.x)], 1u);
        const unsigned gen = old / nloc;
        if (old + 1u == (gen + 1u) * nloc) {
            __builtin_amdgcn_fence(__ATOMIC_RELEASE, "agent");
            asm volatile("s_waitcnt vmcnt(0)" ::: "memory");
            const unsigned og = xb_add(&bar[XB_TOP], 1u);
            const unsigned tg = og / nx;
            if (og + 1u == (tg + 1u) * nx) xb_add(&bar[XB_TOPGEN], 1u);
            else XB_SPIN(xb_ld(&bar[XB_TOPGEN]) == tg, bar);
            __builtin_amdgcn_fence(__ATOMIC_ACQUIRE, "agent");
            xb_add(&bar[XB_XGEN(b.x)], 1u);
            asm volatile("s_waitcnt vmcnt(0)" ::: "memory");
        } else {
            XB_SPIN(xb_ld(&bar[XB_XGEN(b.x)]) == gen, bar);
            __builtin_amdgcn_fence(__ATOMIC_ACQUIRE, "agent");
            asm volatile("s_waitcnt vmcnt(0)" ::: "memory");
        }
    }
    __syncthreads();
}

struct Args { const float* in[28]; float* out; unsigned char* ws; int ph_lo, ph_hi; };

__global__ void __launch_bounds__(512, 2) mega_fwd(Args a) {
    extern __shared__ __attribute__((aligned(16))) unsigned char lds_raw[];
    LAS unsigned char* lds = (LAS unsigned char*)lds_raw;
    const int tid = threadIdx.x, lane = tid & 63, wid = __builtin_amdgcn_readfirstlane(tid >> 6);
    const int G = gridDim.x, bx = blockIdx.x;
    unsigned char* ws = a.ws;
    const int lo = a.ph_lo, hi = a.ph_hi;
#define IN(k) (lo <= (k) && (k) < hi)
#define SYNC_AFTER(k) do { if (IN(k) && IN((k) + 1)) { xcd_barrier(xbar); } } while (0)
    { volatile LAS unsigned* st_ = (volatile LAS unsigned*)(lds + LDS_BYTES - 16); if (tid < 4) st_[tid] = 0u; }
    __syncthreads();
    const XcdBarrier xbar = xcd_barrier_post((unsigned*)(ws + WS_CTL) + 2048, (volatile LAS unsigned*)(lds + LDS_BYTES - 16));
    if (hi > 100) cg::this_grid().sync();
    const float* x = a.in[0];
    bf16_t* H = (bf16_t*)a.out;
    bf16_t* VT = (bf16_t*)((unsigned char*)a.out + 64 * MiB);
    bf16_t* MH = (bf16_t*)(ws + WS_MH);
    float* LOGF = (float*)(ws + WS_LOGF); float* C2 = (float*)(ws + WS_C2); float* SS = (float*)(ws + WS_SS);
    unsigned* CTL = (unsigned*)(ws + WS_CTL);

    if (IN(0)) {
        const int gw = bx * NWAVES + wid, NGW = G * NWAVES;
        LAS float* wl = (LAS float*)lds;
        for (int i = tid; i < 1024 * 8; i += 512) { const int k = i >> 3, g = i & 7; const int j = k >> 8, ln = (k >> 2) & 63, e = k & 3;
            wl[((j * 4 + e) * 64 + ln) * 8 + g] = a.in[3][(size_t)k * INCOLS + 3072 + g]; }
        for (int i = bx * 512 + tid; i < NTOK; i += G * 512) SS[i] = 0.f;
        if (bx == 0 && tid < 64) { float* GN = (float*)(ws + WS_CTL + 4096); const float qs = 0.125f * LOG2E;
            GN[tid] = a.in[5][tid] * qs; GN[64 + tid] = a.in[6][tid]; GN[128 + tid] = a.in[12][tid] * qs; GN[192 + tid] = a.in[13][tid]; }
        __syncthreads();
        LAS float* scr = (LAS float*)(lds + 32768 + wid * 8448);
        constexpr int I0 = 2816, I1 = I0 + 512, I2 = I1 + 256, I3 = I2 + 256, I4 = I3 + 256, I5 = I4 + 256, I6 = I5 + 256, I7 = I6 + 512, I8 = I7 + 2816, I9 = I8 + 1408;
        for (int it = gw; it < I9; it += NGW) {
            if (it < I0) transpose_item(a.in[3], 1024, INCOLS, (bf16_t*)(ws + WS_W1), 176, 0, nullptr, scr, it, lane);
            else if (it < I1) transpose_item(a.in[3], 1024, INCOLS, (bf16_t*)(ws + WS_WV), 32, 1, nullptr, scr, it - I0, lane);
            else if (it < I2) transpose_item(a.in[16], 1024, 1024, (bf16_t*)(ws + WS_WMK), 16, 2, nullptr, scr, it - I1, lane);
            else if (it < I3) transpose_item(a.in[16], 1024, 1024, (bf16_t*)(ws + WS_WMV), 16, 3, nullptr, scr, it - I2, lane);
            else if (it < I4) transpose_item(a.in[19], 512, 1024, (bf16_t*)(ws + WS_WBR), 32, 4, nullptr, scr, it - I3, lane);
            else if (it < I5) transpose_item(a.in[20], 512, 1024, (bf16_t*)(ws + WS_WBR) + 1024 * 512, 32, 4, nullptr, scr, it - I4, lane);
            else if (it < I6) transpose_item(a.in[21], 512, 1024, (bf16_t*)(ws + WS_WBR) + 2 * 1024 * 512, 32, 4, nullptr, scr, it - I5, lane);
            else if (it < I7) transpose_item(a.in[22], 1024, 1024, (bf16_t*)(ws + WS_WOUT), 32, 4, nullptr, scr, it - I6, lane);
            else if (it < I8) transpose_item(a.in[24], 1024, UPN, (bf16_t*)(ws + WS_WUP), 176, 8, a.in[23], scr, it - I7, lane);
            else transpose_item(a.in[27], DFF, 1024, (bf16_t*)(ws + WS_WDN), 32, 4, nullptr, scr, it - I8, lane);
        }
        f32x4 gv[4];
#pragma unroll
        for (int j = 0; j < 4; ++j) gv[j] = ((const f32x4*)a.in[2])[lane + 64 * j];
        const float fbias = a.in[14][lane & 7];
        {
        f32x4 nx[4];
        if (gw < NTOK) { const f32x4* xr = (const f32x4*)(x + (size_t)gw * DM) + lane;
#pragma unroll
            for (int j = 0; j < 4; ++j) nx[j] = xr[64 * j]; }
        for (int m = gw; m < NTOK; m += NGW) {
            f32x4 v[4]; float s = 0.f;
#pragma unroll
            for (int j = 0; j < 4; ++j) v[j] = nx[j];
            if (m + NGW < NTOK) { const f32x4* xr = (const f32x4*)(x + (size_t)(m + NGW) * DM) + lane;
#pragma unroll
                for (int j = 0; j < 4; ++j) nx[j] = xr[64 * j]; }
#pragma unroll
            for (int j = 0; j < 4; ++j) s += (v[j][0] * v[j][0] + v[j][1] * v[j][1]) + (v[j][2] * v[j][2] + v[j][3] * v[j][3]);
            const float rstd = rsqrtf(wave_sum(s) * (1.f / DM) + EPS);
            unsigned long long* o8 = (unsigned long long*)(H + (size_t)m * DM) + lane;
            float fg[8];
#pragma unroll
            for (int g = 0; g < 8; ++g) fg[g] = 0.f;
#pragma unroll
            for (int j = 0; j < 4; ++j) {
                v[j] = v[j] * rstd * gv[j];
                o8[64 * j] = (unsigned long long)cvtpk(v[j][0], v[j][1]) | ((unsigned long long)cvtpk(v[j][2], v[j][3]) << 32);
#pragma unroll
                for (int e = 0; e < 4; ++e) { const LAS f32x4* wp = (const LAS f32x4*)(wl + ((j * 4 + e) * 64 + lane) * 8); const f32x4 w0 = wp[0], w1 = wp[1];
                    fg[0] += v[j][e] * w0[0]; fg[1] += v[j][e] * w0[1]; fg[2] += v[j][e] * w0[2]; fg[3] += v[j][e] * w0[3];
                    fg[4] += v[j][e] * w1[0]; fg[5] += v[j][e] * w1[1]; fg[6] += v[j][e] * w1[2]; fg[7] += v[j][e] * w1[3]; }
            }
            float mine = 0.f;
#pragma unroll
            for (int g = 0; g < 8; ++g) { const float t = wave_sum(fg[g]); if ((lane & 7) == g) mine = t; }
            if (lane < 8) { const float z = mine + fbias; const float lf = fminf(z, 0.f) - log1pf(__expf(-fabsf(z)));
                LOGF[(size_t)((m >> 11) * 8 + lane) * SEQ + (m & 2047)] = lf; }
        }
        }
#pragma unroll
        for (int j = 0; j < 4; ++j) gv[j] = ((const f32x4*)a.in[15])[lane + 64 * j];
        for (int m = gw; m < NMTOK; m += NGW) {
            const f32x4* xr = (const f32x4*)(a.in[1] + (size_t)m * DM) + lane;
            f32x4 v[4]; float s = 0.f;
#pragma unroll
            for (int j = 0; j < 4; ++j) { v[j] = xr[64 * j]; s += (v[j][0] * v[j][0] + v[j][1] * v[j][1]) + (v[j][2] * v[j][2] + v[j][3] * v[j][3]); }
            const float rstd = rsqrtf(wave_sum(s) * (1.f / DM) + EPS);
            unsigned long long* o8 = (unsigned long long*)(MH + (size_t)m * DM) + lane;
#pragma unroll
            for (int j = 0; j < 4; ++j) { v[j] = v[j] * rstd * gv[j]; o8[64 * j] = (unsigned long long)cvtpk(v[j][0], v[j][1]) | ((unsigned long long)cvtpk(v[j][2], v[j][3]) << 32); }
        }
        __syncthreads();
    }
    SYNC_AFTER(0);

    if (IN(1)) {
        if (bx >= G - 16) {
            const int seq = (bx - (G - 16)) * 8 + wid;
            if (seq < NB * 8) {
                const f32x4* src = (const f32x4*)(LOGF + (size_t)seq * SEQ + lane * 32);
                float run = 0.f;
#pragma unroll
                for (int i = 0; i < 8; ++i) { const f32x4 v = src[i]; run += (v[0] + v[1]) + (v[2] + v[3]); }
                float incl = run;
#pragma unroll
                for (int o = 1; o < 64; o <<= 1) { const float t = __shfl_up(incl, o); if (lane >= o) incl += t; }
                float pre = incl - run;
                f32x4* dst = (f32x4*)(C2 + (size_t)seq * SEQ + lane * 32);
#pragma unroll
                for (int i = 0; i < 8; ++i) { f32x4 v = src[i]; v[0] += pre; v[1] += v[0]; v[2] += v[1]; v[3] += v[2]; pre = v[3]; dst[i] = v * LOG2E; }
            }
        }
        { pg8::Gemm g{(const char*)H, (const char*)(ws + WS_W1), 1024, 0, 0, 0}; pg8::Order S; S.init(NTOK, UPN, G, bx, 1);
          EpiProj E{(bf16_t*)(ws + WS_QK), (unsigned char*)(ws + WS_G), (const float*)(ws + WS_CTL + 4096), a.in[4]};
          pg8::gemm_phase<EpiProj>(lds, g, S, E); }
        { pg8::Gemm g{(const char*)(ws + WS_WV), (const char*)H, 1024, 0, 0, 0}; pg8::Order S; S.init(1024, NTOK, G, bx, 1);
          EpiNat E{VT, NTOK};
          pg8::gemm_phase<EpiNat>(lds, g, S, E); }
    }
    SYNC_AFTER(1);

    if (IN(2)) {
        AttnP P{(const bf16_t*)(ws + WS_QK), VT, (const bf16_t*)(ws + WS_MK), (const bf16_t*)(ws + WS_MVT), C2, (bf16_t*)(ws + WS_O), a.out,
                a.in[7], a.in[8], a.in[9], a.in[10], a.in[11], a.in[17], a.in[18], (const float*)(ws + WS_CTL + 4096)};
        LAS int* uw = (LAS int*)(lds + AT_UNITW);
        for (int j = bx; j < 64; j += G) {
            if (j < 32) { pg8::Gemm g{(const char*)MH, (const char*)(ws + WS_WMK), 1024, 0, 0, 0}; pg8::Order S; S.init(NMTOK, 512, 32, j, 1);
                EpiPlain E{(bf16_t*)(ws + WS_MK), 512};
                pg8::gemm_phase<EpiPlain>(lds, g, S, E); }
            else { pg8::Gemm g{(const char*)(ws + WS_WMV), (const char*)MH, 1024, 0, 0, 0}; pg8::Order S; S.init(512, NMTOK, 32, j - 32, 1);
                EpiNat E{(bf16_t*)(ws + WS_MVT), NMTOK};
                pg8::gemm_phase<EpiNat>(lds, g, S, E); }
            asm volatile("s_waitcnt vmcnt(0)" ::: "memory");
            __syncthreads();
            if (tid == 0) { __builtin_amdgcn_fence(__ATOMIC_RELEASE, "agent"); asm volatile("s_waitcnt vmcnt(0)" ::: "memory");
                __hip_atomic_fetch_add(CTL + 128, 1u, __ATOMIC_RELAXED, __HIP_MEMORY_SCOPE_AGENT); }
        }
        bool mem_ready = false;
        int idx = bx;
        if (wid >= 4) __builtin_amdgcn_s_setprio(1);
        for (;;) {
            if (idx >= N_ATT_UNITS) break;
            unsigned nxt = 0u;
            if (tid == 0) nxt = atomicAdd(CTL, 1u);
            int kind, qb, sub; decode_unit(idx, kind, qb, sub);
            if (kind == 0) attn_unit<0>(lds, P, sub >> 2, sub & 3, qb);
            else if (kind == 1) attn_fx64(lds, P, sub >> 3, sub & 7, qb);
            else {
                if (!mem_ready) {
                    if (tid == 0) { while (__hip_atomic_load(CTL + 128, __ATOMIC_RELAXED, __HIP_MEMORY_SCOPE_AGENT) < 64u) __builtin_amdgcn_s_sleep(8);
                        __builtin_amdgcn_fence(__ATOMIC_ACQUIRE, "agent"); asm volatile("s_waitcnt vmcnt(0)" ::: "memory"); }
                    __syncthreads();
                    mem_ready = true;
                }
                attn_unit<2>(lds, P, sub >> 2, sub & 3, qb);
            }
            if (tid == 0) *uw = G + (int)nxt;
            __syncthreads();
            idx = __builtin_amdgcn_readfirstlane(*uw);
            __syncthreads();
        }
        __builtin_amdgcn_s_setprio(0);
    }
    SYNC_AFTER(2);

    if (IN(3)) {
        pg8::Gemm g{(const char*)(ws + WS_O), (const char*)(ws + WS_WBR), 512, 0, (size_t)NTOK * 512 * 2, (size_t)1024 * 512 * 2}; pg8::Order S; S.init(NTOK, DM, G, bx, 3);
        EpiMerge E{(const unsigned char*)(ws + WS_G), (bf16_t*)(ws + WS_MERGED)};
        pg8::gemm_phase<EpiMerge>(lds, g, S, E);
    }
    SYNC_AFTER(3);

    if (IN(4)) {
        pg8::Gemm g{(const char*)(ws + WS_MERGED), (const char*)(ws + WS_WOUT), 1024, 0, 0, 0}; pg8::Order S; S.init(NTOK, DM, G, bx, 1);
        EpiOut E{x, a.out, (bf16_t*)(ws + WS_X1B), SS};
        pg8::gemm_phase<EpiOut>(lds, g, S, E);
    }
    SYNC_AFTER(4);

    if (IN(5)) {
        pg8::Gemm g{(const char*)(ws + WS_X1B), (const char*)(ws + WS_WUP), 1024, 1, 0, 0}; pg8::Order S; S.init(NTOK, UPN, G, bx, 1);
        EpiUp E{SS, a.in[25], a.in[26], (bf16_t*)(ws + WS_ACT), (float*)(ws + WS_UB)};
        pg8::gemm_phase<EpiUp>(lds, g, S, E);
    }
    SYNC_AFTER(5);

    if (IN(6)) {
        pg8::Order S; S.init(NTOK, DM, G, bx, 1);
        const float* UB = (const float*)(ws + WS_UB); bf16_t* ACT = (bf16_t*)(ws + WS_ACT);
        const float* cw = a.in[25]; const float* cb = a.in[26];
        Unit u;
        for (int i = 0; S.next(i, u); ++i) {
            for (int gg = 0; gg < 2; ++gg) {
                const int grp = u.pm * 2 + gg; const bool hasprev = (grp & 15) != 0;
                const float* ub = UB + (size_t)grp * DFF * 8; const float* pb = UB + (size_t)(grp - 1) * DFF * 8 + 4;
                for (int ch = tid; ch < DFF; ch += 512) {
                    const f32x4 uf = *(const f32x4*)(ub + (size_t)ch * 8);
                    const float u0a = uf[0], u0g = uf[1], u1a = uf[2], u1g = uf[3];
                    float p2a = 0.f, p1a = 0.f, p2g = 0.f, p1g = 0.f;
                    if (hasprev) { const f32x4 pf_ = *(const f32x4*)(pb + (size_t)ch * 8); p2a = pf_[0]; p2g = pf_[1]; p1a = pf_[2]; p1g = pf_[3]; }
                    const float wa0 = cw[ch], wa1 = cw[UPN + ch], wa2 = cw[2 * UPN + ch], ba = cb[ch];
                    const float wg0 = cw[DFF + ch], wg1 = cw[UPN + DFF + ch], wg2 = cw[2 * UPN + DFF + ch], bg = cb[DFF + ch];
                    const float ca0 = wa0 * p2a + wa1 * p1a + wa2 * u0a + ba, cg0 = wg0 * p2g + wg1 * p1g + wg2 * u0g + bg;
                    const float ca1 = wa0 * p1a + wa1 * u0a + wa2 * u1a + ba, cg1 = wg0 * p1g + wg1 * u0g + wg2 * u1g + bg;
                    const unsigned w0 = cvtpk(ca0 * sigmoidf_(ca0) * cg0, 0.f), w1 = cvtpk(ca1 * sigmoidf_(ca1) * cg1, 0.f);
                    ACT[(size_t)(grp * 128) * DFF + ch] = (bf16_t)(w0 & 0xffffu);
                    ACT[(size_t)(grp * 128 + 1) * DFF + ch] = (bf16_t)(w1 & 0xffffu);
                }
            }
        }
        asm volatile("s_waitcnt vmcnt(0)" ::: "memory");
        __syncthreads();
        pg8::Gemm g{(const char*)(ws + WS_ACT), (const char*)(ws + WS_WDN), DFF, 0, 0, 0};
        EpiDown E{a.out, (const bf16_t*)(ws + WS_X1B)};
        pg8::gemm_phase<EpiDown>(lds, g, S, E);
    }
#undef IN
#undef SYNC_AFTER
}

extern "C" void kernel_launch(void* const* d_in, const int* in_sizes, int n_in, void* d_out, int out_size, void* d_ws, size_t ws_size, hipStream_t stream) {
    static int grid = 0;
    if (grid == 0) {
        int dev = 0, cus = 0, per_cu = 0;
        if (hipGetDevice(&dev) != hipSuccess || hipDeviceGetAttribute(&cus, hipDeviceAttributeMultiprocessorCount, dev) != hipSuccess) { fprintf(stderr, "kernel_launch: device query failed\n"); grid = -1; return; }
        if (hipFuncSetAttribute((const void*)mega_fwd, hipFuncAttributeMaxDynamicSharedMemorySize, LDS_BYTES) != hipSuccess) { fprintf(stderr, "kernel_launch: hipFuncSetAttribute failed\n"); grid = -1; return; }
        if (hipOccupancyMaxActiveBlocksPerMultiprocessor(&per_cu, (const void*)mega_fwd, 512, LDS_BYTES) != hipSuccess || per_cu < 1) { fprintf(stderr, "kernel_launch: occupancy query says %d\n", per_cu); per_cu = 1; }
        (void)hipGetLastError();
        grid = cus * per_cu;
        if (n_in != 28 || ws_size < 512 * MiB) fprintf(stderr, "kernel_launch: unexpected n_in %d / ws %zu\n", n_in, ws_size);
    }
    if (grid < 0) return;
    Args a{};
    for (int i = 0; i < 28; ++i) a.in[i] = (const float*)d_in[i];
    a.out = (float*)d_out; a.ws = (unsigned char*)d_ws;
#if MK_PER_PHASE
    for (int p = 0; p < 7; ++p) { a.ph_lo = p; a.ph_hi = p + 1; hipLaunchKernelGGL(mega_fwd, dim3(grid), dim3(512), LDS_BYTES, stream, a); }
#else
    (void)hipMemsetAsync(d_ws, 0, 24576, stream);
    a.ph_lo = 0; a.ph_hi = 7;
    void* args[] = {&a};
    hipError_t e = hipLaunchCooperativeKernel((const void*)mega_fwd, dim3(grid), dim3(512), args, LDS_BYTES, stream);
    if (e != hipSuccess) fprintf(stderr, "kernel_launch: cooperative launch failed: %s (grid %d)\n", hipGetErrorString(e), grid);
#endif
}
```

```cpp
#include <hip/hip_runtime.h>
#include <hip/hip_cooperative_groups.h>
#include <cstdio>
#include <cstdint>
namespace cg = cooperative_groups;

#ifndef MK_PER_PHASE
#define MK_PER_PHASE 0
#endif

#define LAS __attribute__((address_space(3)))
typedef unsigned short bf16_t;
typedef short bf16x8 __attribute__((ext_vector_type(8)));
typedef short s16x4 __attribute__((ext_vector_type(4)));
typedef float f32x4 __attribute__((ext_vector_type(4)));
typedef float f32x16 __attribute__((ext_vector_type(16)));
typedef float f32x2 __attribute__((ext_vector_type(2)));
typedef unsigned u32x4 __attribute__((ext_vector_type(4)));
typedef unsigned u32x2 __attribute__((ext_vector_type(2)));
typedef __bf16 bf16x2_t __attribute__((ext_vector_type(2)));

constexpr int DM = 1024, NB = 16, SEQ = 2048, NTOK = NB * SEQ, NMEM = 256, NMTOK = NB * NMEM;
constexpr int INCOLS = 6664, DFF = 2816, UPN = 5632;
constexpr float EPS = 1e-6f, LOG2E = 1.4426950408889634f;
constexpr int QKP = 2560, GP = 3072;
constexpr int NWAVES = 8;
constexpr int LDS_BYTES = 147456;

constexpr size_t MiB = 1u << 20;
constexpr size_t WS_CTL = 0, WS_LOGF = 1 * MiB, WS_C2 = 2 * MiB, WS_SS = 3 * MiB, WS_MK = 4 * MiB, WS_MVT = 8 * MiB;
constexpr size_t WS_W1 = 12 * MiB, WS_WV = 23 * MiB, WS_WMK = 25 * MiB, WS_WMV = 26 * MiB, WS_WBR = 27 * MiB, WS_WOUT = 30 * MiB;
constexpr size_t WS_WUP = 32 * MiB, WS_WDN = 43 * MiB, WS_MH = 56 * MiB;
constexpr size_t WS_QK = 64 * MiB, WS_G = 224 * MiB, WS_O = 416 * MiB;
constexpr size_t WS_MERGED = 64 * MiB, WS_X1B = 128 * MiB, WS_ACT = 224 * MiB, WS_UB = 400 * MiB;

__device__ __forceinline__ unsigned cvtpk(float lo, float hi) { f32x2 v = {lo, hi}; bf16x2_t b = __builtin_convertvector(v, bf16x2_t); return __builtin_bit_cast(unsigned, b); }
__device__ __forceinline__ float bf2f(unsigned short b) { return __uint_as_float((unsigned)b << 16); }
__device__ __forceinline__ float bflo(unsigned w) { return __uint_as_float(w << 16); }
__device__ __forceinline__ float bfhi(unsigned w) { return __uint_as_float(w & 0xffff0000u); }
__device__ __forceinline__ float dpp_shr1(float v) { return __int_as_float(__builtin_amdgcn_update_dpp(0, __float_as_int(v), 0x111  , 0xf, 0xf, false)); }
__device__ __forceinline__ float wave_sum(float v) {
    v += __int_as_float(__builtin_amdgcn_update_dpp(0, __float_as_int(v), 0xB1, 0xf, 0xf, false));
    v += __int_as_float(__builtin_amdgcn_update_dpp(0, __float_as_int(v), 0x4E, 0xf, 0xf, false));
    v += __int_as_float(__builtin_amdgcn_update_dpp(0, __float_as_int(v), 0x141, 0xf, 0xf, false));
    v += __int_as_float(__builtin_amdgcn_update_dpp(0, __float_as_int(v), 0x140, 0xf, 0xf, false));
    v += __int_as_float(__builtin_amdgcn_update_dpp(0, __float_as_int(v), 0x142, 0xa, 0xf, false));
    v += __int_as_float(__builtin_amdgcn_update_dpp(0, __float_as_int(v), 0x143, 0xc, 0xf, false));
    return __int_as_float(__builtin_amdgcn_readlane(__float_as_int(v), 63));
}
__device__ __forceinline__ float sum_fq(float v) {
    { const auto r = __builtin_amdgcn_permlane16_swap(__float_as_uint(v), __float_as_uint(v), false, false); v = __uint_as_float(r[0]) + __uint_as_float(r[1]); }
    { const auto r = __builtin_amdgcn_permlane32_swap(__float_as_uint(v), __float_as_uint(v), false, false); v = __uint_as_float(r[0]) + __uint_as_float(r[1]); }
    return v;
}
__device__ __forceinline__ float row16_sum(float v) {
    v += __int_as_float(__builtin_amdgcn_update_dpp(0, __float_as_int(v), 0xB1, 0xf, 0xf, false));
    v += __int_as_float(__builtin_amdgcn_update_dpp(0, __float_as_int(v), 0x4E, 0xf, 0xf, false));
    v += __int_as_float(__builtin_amdgcn_update_dpp(0, __float_as_int(v), 0x141, 0xf, 0xf, false));
    v += __int_as_float(__builtin_amdgcn_update_dpp(0, __float_as_int(v), 0x140, 0xf, 0xf, false));
    return v;
}
__device__ __forceinline__ float fast_exp2(float x) { return __builtin_amdgcn_exp2f(x); }
__device__ __forceinline__ float fast_rcp(float x) { return __builtin_amdgcn_rcpf(x); }
__device__ __forceinline__ float sigmoidf_(float z) { return fast_rcp(1.f + fast_exp2(-z * LOG2E)); }

namespace pg8 {
constexpr int BM = 256, BK = 64, HALF = 128, HTB = HALF * BK * 2, STAGE_BYTES = 8 * HTB, NXCD = 8, WGM = 8;
__host__ __device__ __forceinline__ int lds_byte(int r, int c) { const int st = (r >> 4) * 2 + (c >> 5), rr = r & 15, cc = c & 31, ob = rr * 64 + cc * 2; return st * 1024 + (ob ^ (((ob >> 9) & 1) << 5)); }
__host__ __device__ __forceinline__ void stage_rc(int b, int& R, int& C) { const int st = b / 1024, sb = b % 1024, swz = sb ^ (((sb >> 9) & 1) << 5); R = (st >> 1) * 16 + swz / 64; C = (st & 1) * 32 + (swz % 64) / 2; }

struct Unit { int pm, pn, seg; };
struct Gemm { const char* A; const char* Bt; int K; int a_perm; size_t a_seg, b_seg; };

struct Order {
    int nM, nN, nwg, G, c, nseg;
    __device__ void init(int M, int N, int G_, int c_, int nseg_) { nM = M / BM; nN = N / BM; nwg = nM * nN; G = G_; c = c_; nseg = nseg_; }
    __device__ bool next(int i, Unit& u) const {
        const int seg = i % nseg, ii = i / nseg;
        const long L = (long)ii * G + c; if (L >= nwg) return false;
        int wgid = (int)L; { const int q = nwg / NXCD, r = nwg % NXCD, xcd = wgid % NXCD, off = wgid / NXCD; wgid = (xcd < r ? xcd * (q + 1) : r * (q + 1) + (xcd - r) * q) + off; }
        const int nig = WGM * nN, gid = wgid / nig, fm = gid * WGM, gsz = (nM - fm) < WGM ? (nM - fm) : WGM;
        u.pm = fm + ((wgid % nig) % gsz); u.pn = (wgid % nig) / gsz; u.seg = seg; return true;
    }
};

template <class Epi>
__device__ __forceinline__ void gemm_phase(LAS unsigned char* lds, const Gemm g, const Order& S, const Epi& E) {
    const int tid = threadIdx.x, wid = __builtin_amdgcn_readfirstlane(tid >> 6), lane = tid & 63, wr = wid >> 2, wc = wid & 3, fr = lane & 15, fq = lane >> 4;
    const int K = g.K, nt = K / BK;
    unsigned voffA[2], voffB[2];
#pragma unroll
    for (int i = 0; i < 2; ++i) { int R, C; stage_rc(tid * 16 + i * 8192, R, C);
        const int Ra = g.a_perm ? (8 * (16 * (R >> 6) + (R & 15)) + ((R >> 4) & 3)) : R;
        voffA[i] = (unsigned)(Ra * K + C) * 2u; voffB[i] = (unsigned)(R * K + C) * 2u; }
    const size_t kstep = (size_t)(BK * 2);
    const size_t hstep = (size_t)HALF * K * 2;
    const size_t hstepA = g.a_perm ? (size_t)4 * K * 2 : hstep;
    const size_t tstep = 2 * hstep;
    const unsigned ldsw = (unsigned)wid * 1024u;
    const int aoff = lds_byte(wr * 64 + fr, fq * 8), boff = lds_byte(wc * 32 + fr, fq * 8);
#define PG8_SA(b, h) (((b) * 2 + (h)) * HTB)
#define PG8_SB(b, h) ((4 + (b) * 2 + (h)) * HTB)
#define PG8_STAGE(bufoff, gbase, voff) do { _Pragma("unroll") for (int _i = 0; _i < 2; ++_i) \
        __builtin_amdgcn_global_load_lds((const unsigned*)((const char*)(gbase) + (voff)[_i]), (LAS unsigned*)(lds + (bufoff) + ldsw + _i * 8192), 16, 0, 0); } while (0)
#define PG8_LDA(dst, b, h) do { _Pragma("unroll") for (int m = 0; m < 4; ++m) _Pragma("unroll") for (int k = 0; k < 2; ++k) dst[m][k] = *(const LAS bf16x8*)(lds + PG8_SA(b, h) + aoff + m * 2048 + k * 1024); } while (0)
#define PG8_LDB(dst, b, h) do { _Pragma("unroll") for (int n = 0; n < 2; ++n) _Pragma("unroll") for (int k = 0; k < 2; ++k) dst[n][k] = *(const LAS bf16x8*)(lds + PG8_SB(b, h) + boff + n * 2048 + k * 1024); } while (0)
#define PG8_MMA(ai, bj, At, Bt) do { __builtin_amdgcn_s_setprio(1); _Pragma("unroll") for (int m = 0; m < 4; ++m) _Pragma("unroll") for (int n = 0; n < 2; ++n) _Pragma("unroll") for (int k = 0; k < 2; ++k) \
        acc[ai][bj][m][n] = __builtin_amdgcn_mfma_f32_16x16x32_bf16(Bt[n][k], At[m][k], acc[ai][bj][m][n], 0, 0, 0); __builtin_amdgcn_s_setprio(0); } while (0)
#define PG8_WAIT_V(n) asm volatile("s_waitcnt vmcnt(" #n ")" ::: "memory")
#define PG8_WAIT_L(n) asm volatile("s_waitcnt lgkmcnt(" #n ")" ::: "memory")
#define PG8_BAR __builtin_amdgcn_s_barrier()
#define PG8_SCHED __builtin_amdgcn_sched_barrier(0)
    Unit cur, nxt; int ui = 0;
    if (!S.next(0, cur)) return;
    f32x4 acc[2][2][4][2];
#pragma unroll
    for (int a = 0; a < 2; ++a)
#pragma unroll
        for (int b = 0; b < 2; ++b)
#pragma unroll
            for (int m = 0; m < 4; ++m)
#pragma unroll
                for (int n = 0; n < 2; ++n) acc[a][b][m][n] = (f32x4){0.f, 0.f, 0.f, 0.f};
    bf16x8 At[4][2], B0[2][2], B1[2][2];
    const char* cA = g.A + (size_t)cur.pm * tstep + (size_t)cur.seg * g.a_seg; const char* cB = g.Bt + (size_t)cur.pn * tstep + (size_t)cur.seg * g.b_seg;
    PG8_STAGE(PG8_SB(0, 0), cB, voffB); PG8_STAGE(PG8_SB(0, 1), cB + hstep, voffB); PG8_STAGE(PG8_SA(0, 0), cA, voffA); PG8_STAGE(PG8_SA(0, 1), cA + hstepA, voffA);
    if (wr == 1) PG8_BAR;
    PG8_WAIT_V(2); PG8_BAR;
    PG8_STAGE(PG8_SB(1, 0), cB + kstep, voffB); PG8_STAGE(PG8_SA(1, 0), cA + kstep, voffA); PG8_STAGE(PG8_SB(1, 1), cB + hstep + kstep, voffB);
    PG8_WAIT_V(6); PG8_BAR;
    for (;;) {
        const bool has_next = S.next(ui + 1, nxt);
        const char* nA = has_next ? g.A + (size_t)nxt.pm * tstep + (size_t)nxt.seg * g.a_seg : cA; const char* nB = has_next ? g.Bt + (size_t)nxt.pn * tstep + (size_t)nxt.seg * g.b_seg : cB;
        for (int t = 0; t < nt; t += 2) {
            const bool last = (t == nt - 2);
            const char* a1 = cA + (size_t)(t + 1) * kstep;
            const char* a2 = last ? nA : cA + (size_t)(t + 2) * kstep; const char* b2 = last ? nB : cB + (size_t)(t + 2) * kstep;
            const char* a3 = a2 + kstep; const char* b3 = b2 + kstep;
            PG8_LDB(B0, 0, 0); PG8_LDB(B1, 0, 1); PG8_SCHED; PG8_LDA(At, 0, 0); PG8_STAGE(PG8_SA(1, 1), a1 + hstepA, voffA);
            PG8_WAIT_V(8); PG8_WAIT_L(0); PG8_BAR; PG8_MMA(0, 0, At, B0); PG8_MMA(0, 1, At, B1); PG8_BAR; PG8_SCHED;
            PG8_LDA(At, 0, 1); PG8_STAGE(PG8_SB(0, 0), b2, voffB); PG8_STAGE(PG8_SB(0, 1), b2 + hstep, voffB); PG8_STAGE(PG8_SA(0, 0), a2, voffA);
            PG8_WAIT_V(8); PG8_WAIT_L(0); PG8_BAR; PG8_MMA(1, 0, At, B0); PG8_MMA(1, 1, At, B1); PG8_BAR; PG8_SCHED;
            PG8_LDB(B0, 1, 0); PG8_LDB(B1, 1, 1); PG8_SCHED; PG8_LDA(At, 1, 0); PG8_STAGE(PG8_SA(0, 1), a2 + hstepA, voffA);
            PG8_WAIT_V(8); PG8_WAIT_L(0); PG8_BAR; PG8_MMA(0, 0, At, B0); PG8_MMA(0, 1, At, B1); PG8_BAR; PG8_SCHED;
            PG8_LDA(At, 1, 1); PG8_STAGE(PG8_SB(1, 0), b3, voffB); PG8_STAGE(PG8_SB(1, 1), b3 + hstep, voffB); PG8_STAGE(PG8_SA(1, 0), a3, voffA);
            PG8_WAIT_V(8); PG8_WAIT_L(0); PG8_BAR; PG8_MMA(1, 0, At, B0); PG8_MMA(1, 1, At, B1); PG8_BAR; PG8_SCHED;
        }
        if (wr == 0) PG8_BAR;
        E(acc, cur, wr, wc, fr, fq);
        if (!has_next) break;
        if (E.reset_after(cur))
#pragma unroll
        for (int a = 0; a < 2; ++a)
#pragma unroll
            for (int b = 0; b < 2; ++b)
#pragma unroll
                for (int m = 0; m < 4; ++m)
#pragma unroll
                    for (int n = 0; n < 2; ++n) acc[a][b][m][n] = (f32x4){0.f, 0.f, 0.f, 0.f};
        cur = nxt; cA = nA; cB = nB; ++ui;
        if (wr == 1) PG8_BAR;
    }
    PG8_WAIT_V(0);
    PG8_BAR;
#undef PG8_SA
#undef PG8_SB
#undef PG8_STAGE
#undef PG8_LDA
#undef PG8_LDB
#undef PG8_MMA
#undef PG8_WAIT_V
#undef PG8_WAIT_L
#undef PG8_BAR
#undef PG8_SCHED
}
}
using pg8::Unit;
typedef f32x4 Acc[2][2][4][2];

__device__ __forceinline__ int perm16(int c) { return ((c >> 5) & 3) * 64 + ((c >> 2) & 3) * 16 + (c >> 7) * 8 + ((c >> 4) & 1) * 4 + (c & 3); }

struct EpiProj {
    __device__ __forceinline__ bool reset_after(const Unit&) const { return true; }
    bf16_t* QK; unsigned char* G; const float* GN; const float* b_gate;
    __device__ __forceinline__ void operator()(const Acc& acc, const Unit& u, int wr, int wc, int fr, int fq) const {
        const int row0 = u.pm * 256 + wr * 64 + fr, lcol = wc * 64 + fq * 16;
        if (u.pn < 10) {
            const int kind = u.pn >> 1;
            bf16_t* base = QK + (size_t)row0 * QKP + u.pn * 256 + lcol;
            if (kind < 4) {
                const float* gp = GN + kind * 64 + fq * 16;
                const f32x4 gn0 = *(const f32x4*)(gp), gn1 = *(const f32x4*)(gp + 4), gn2 = *(const f32x4*)(gp + 8), gn3 = *(const f32x4*)(gp + 12);
#pragma unroll
                for (int ai = 0; ai < 2; ++ai)
#pragma unroll
                    for (int m = 0; m < 4; ++m) {
                        float ss = 0.f;
#pragma unroll
                        for (int bj = 0; bj < 2; ++bj)
#pragma unroll
                            for (int n = 0; n < 2; ++n) { const f32x4 v = acc[ai][bj][m][n]; ss += (v[0] * v[0] + v[1] * v[1]) + (v[2] * v[2] + v[3] * v[3]); }
                        ss = sum_fq(ss);
                        const float rs = rsqrtf(ss * (1.f / 64.f) + EPS);
                        bf16_t* rowp = base + (size_t)(ai * 128 + m * 16) * QKP;
#pragma unroll
                        for (int bj = 0; bj < 2; ++bj) {
                            const f32x4 v0 = acc[ai][bj][m][0] * rs * (bj ? gn2 : gn0), v1 = acc[ai][bj][m][1] * rs * (bj ? gn3 : gn1);
                            u32x4 w; w.x = cvtpk(v0[0], v0[1]); w.y = cvtpk(v0[2], v0[3]); w.z = cvtpk(v1[0], v1[1]); w.w = cvtpk(v1[2], v1[3]);
                            *(u32x4*)(rowp + 8 * bj) = w; }
                    }
            } else {
#pragma unroll
                for (int ai = 0; ai < 2; ++ai)
#pragma unroll
                    for (int m = 0; m < 4; ++m) {
                        bf16_t* rowp = base + (size_t)(ai * 128 + m * 16) * QKP;
#pragma unroll
                        for (int bj = 0; bj < 2; ++bj) {
                            const f32x4 v0 = acc[ai][bj][m][0], v1 = acc[ai][bj][m][1];
                            u32x4 w; w.x = cvtpk(v0[0], v0[1]); w.y = cvtpk(v0[2], v0[3]); w.z = cvtpk(v1[0], v1[1]); w.w = cvtpk(v1[2], v1[3]);
                            *(u32x4*)(rowp + 8 * bj) = w; }
                    }
            }
        } else {
            const int col = (u.pn - 10) * 256 + lcol;
            unsigned char* base = G + (size_t)row0 * GP + col;
            const f32x4 bv0 = *(const f32x4*)(b_gate + col), bv1 = *(const f32x4*)(b_gate + col + 4), bv2 = *(const f32x4*)(b_gate + col + 8), bv3 = *(const f32x4*)(b_gate + col + 12);
#pragma unroll
            for (int ai = 0; ai < 2; ++ai)
#pragma unroll
                for (int m = 0; m < 4; ++m) {
                    u32x4 w;
#pragma unroll
                    for (int bj = 0; bj < 2; ++bj)
#pragma unroll
                        for (int n = 0; n < 2; ++n) {
                            const f32x4 v = acc[ai][bj][m][n] + (bj ? (n ? bv3 : bv2) : (n ? bv1 : bv0));
                            const unsigned q0 = (unsigned)(sigmoidf_(v[0]) * 255.f + 0.5f), q1 = (unsigned)(sigmoidf_(v[1]) * 255.f + 0.5f), q2 = (unsigned)(sigmoidf_(v[2]) * 255.f + 0.5f), q3 = (unsigned)(sigmoidf_(v[3]) * 255.f + 0.5f);
                            w[2 * bj + n] = q0 | (q1 << 8) | (q2 << 16) | (q3 << 24);
                        }
                    *(u32x4*)(base + (size_t)(ai * 128 + m * 16) * GP) = w;
                }
        }
    }
};
struct EpiNat {
    __device__ __forceinline__ bool reset_after(const Unit&) const { return true; }
    bf16_t* O; int ldc;
    __device__ __forceinline__ void operator()(const Acc& acc, const Unit& u, int wr, int wc, int fr, int fq) const {
        bf16_t* base = O + (size_t)(u.pm * 256 + wr * 64 + fr) * ldc + u.pn * 256 + wc * 32 + fq * 4;
#pragma unroll
        for (int ai = 0; ai < 2; ++ai)
#pragma unroll
            for (int m = 0; m < 4; ++m) {
                bf16_t* rowp = base + (size_t)(ai * 128 + m * 16) * ldc;
#pragma unroll
                for (int bj = 0; bj < 2; ++bj)
#pragma unroll
                    for (int n = 0; n < 2; ++n) { const f32x4 v = acc[ai][bj][m][n]; u32x2 w; w.x = cvtpk(v[0], v[1]); w.y = cvtpk(v[2], v[3]); *(u32x2*)(rowp + bj * 128 + n * 16) = w; }
            }
    }
};
struct EpiPlain {
    __device__ __forceinline__ bool reset_after(const Unit&) const { return true; }
    bf16_t* O; int ldc;
    __device__ __forceinline__ void operator()(const Acc& acc, const Unit& u, int wr, int wc, int fr, int fq) const {
        bf16_t* base = O + (size_t)(u.pm * 256 + wr * 64 + fr) * ldc + u.pn * 256 + wc * 64 + fq * 16;
#pragma unroll
        for (int ai = 0; ai < 2; ++ai)
#pragma unroll
            for (int m = 0; m < 4; ++m) {
                bf16_t* rowp = base + (size_t)(ai * 128 + m * 16) * ldc;
#pragma unroll
                for (int bj = 0; bj < 2; ++bj) {
                    const f32x4 v0 = acc[ai][bj][m][0], v1 = acc[ai][bj][m][1];
                    u32x4 w; w.x = cvtpk(v0[0], v0[1]); w.y = cvtpk(v0[2], v0[3]); w.z = cvtpk(v1[0], v1[1]); w.w = cvtpk(v1[2], v1[3]);
                    *(u32x4*)(rowp + 8 * bj) = w; }
            }
    }
};
__device__ __forceinline__ f32x4 gate4(unsigned w) { f32x4 g; g[0] = (float)(w & 0xffu); g[1] = (float)((w >> 8) & 0xffu); g[2] = (float)((w >> 16) & 0xffu); g[3] = (float)(w >> 24);
    g[0] = fmaxf(g[0], 1e-3f); g[1] = fmaxf(g[1], 1e-3f); g[2] = fmaxf(g[2], 1e-3f); g[3] = fmaxf(g[3], 1e-3f); return g; }
struct EpiMerge {
    __device__ __forceinline__ bool reset_after(const Unit& u) const { return u.seg == 2; }
    const unsigned char* G; bf16_t* MERGED;
    __device__ __forceinline__ void operator()(Acc& acc, const Unit& u, int wr, int wc, int fr, int fq) const {
        const int row0 = u.pm * 256 + wr * 64 + fr, col = u.pn * 256 + wc * 64 + fq * 16;
        const unsigned char* gbase = G + (size_t)row0 * GP + u.seg * 1024 + col;
        u32x4 gn[8], gd[8];
#pragma unroll
        for (int i = 0; i < 8; ++i) gn[i] = *(const u32x4*)(gbase + (size_t)((i >> 2) * 128 + (i & 3) * 16) * GP);
        if (u.seg < 2) {
#pragma unroll
            for (int i = 0; i < 8; ++i) gd[i] = *(const u32x4*)(gbase + (size_t)((i >> 2) * 128 + (i & 3) * 16) * GP + 1024);
        }
        asm volatile("" ::: "memory");
#pragma unroll
        for (int ai = 0; ai < 2; ++ai)
#pragma unroll
            for (int m = 0; m < 4; ++m) {
                const size_t row = (size_t)(row0 + ai * 128 + m * 16);
                const u32x4 gnw = gn[ai * 4 + m];
                if (u.seg < 2) {
                    const u32x4 gdw = gd[ai * 4 + m];
#pragma unroll
                    for (int bj = 0; bj < 2; ++bj)
#pragma unroll
                        for (int n = 0; n < 2; ++n) { const f32x4 a_ = gate4(gnw[2 * bj + n]), d_ = gate4(gdw[2 * bj + n]); f32x4 r;
                            r[0] = a_[0] * fast_rcp(d_[0]); r[1] = a_[1] * fast_rcp(d_[1]); r[2] = a_[2] * fast_rcp(d_[2]); r[3] = a_[3] * fast_rcp(d_[3]);
                            acc[ai][bj][m][n] *= r; }
                } else {
                    bf16_t* mp = MERGED + row * DM + col;
#pragma unroll
                    for (int bj = 0; bj < 2; ++bj) {
                        const f32x4 v0 = acc[ai][bj][m][0] * gate4(gnw[2 * bj]) * (1.f / 255.f), v1 = acc[ai][bj][m][1] * gate4(gnw[2 * bj + 1]) * (1.f / 255.f);
                        u32x4 w; w.x = cvtpk(v0[0], v0[1]); w.y = cvtpk(v0[2], v0[3]); w.z = cvtpk(v1[0], v1[1]); w.w = cvtpk(v1[2], v1[3]);
                        *(u32x4*)(mp + 8 * bj) = w; }
                }
            }
    }
};
struct EpiOut {
    __device__ __forceinline__ bool reset_after(const Unit&) const { return true; }
    const float* X; float* OUT; bf16_t* X1B; float* SS;
    __device__ __forceinline__ void operator()(const Acc& acc, const Unit& u, int wr, int wc, int fr, int fq) const {
        const int row0 = u.pm * 256 + wr * 64 + fr, col = u.pn * 256 + wc * 64 + fq * 16;
        f32x4 xv[4][4];
#pragma unroll
        for (int i = 0; i < 4; ++i) { const float* xp = X + (size_t)(row0 + i * 16) * DM + col;
#pragma unroll
            for (int q = 0; q < 4; ++q) xv[i][q] = *(const f32x4*)(xp + 4 * q); }
        asm volatile("" ::: "memory");
#pragma unroll
        for (int i = 0; i < 8; ++i) {
            const int ai = i >> 2, m = i & 3;
            const size_t row = (size_t)(row0 + ai * 128 + m * 16);
            float ss = 0.f;
#pragma unroll
            for (int bj = 0; bj < 2; ++bj) {
                const f32x4 v0 = acc[ai][bj][m][0] + xv[i & 3][2 * bj], v1 = acc[ai][bj][m][1] + xv[i & 3][2 * bj + 1];
                ss += (v0[0] * v0[0] + v0[1] * v0[1]) + (v0[2] * v0[2] + v0[3] * v0[3]) + (v1[0] * v1[0] + v1[1] * v1[1]) + (v1[2] * v1[2] + v1[3] * v1[3]);
                u32x4 w; w.x = cvtpk(v0[0], v0[1]); w.y = cvtpk(v0[2], v0[3]); w.z = cvtpk(v1[0], v1[1]); w.w = cvtpk(v1[2], v1[3]);
                *(u32x4*)(X1B + row * DM + col + 8 * bj) = w;
            }
            if (i < 4) { const float* xp = X + (size_t)(row0 + 128 + i * 16) * DM + col;
#pragma unroll
                for (int q = 0; q < 4; ++q) xv[i][q] = *(const f32x4*)(xp + 4 * q); }
            ss = sum_fq(ss);
            if (fq == 0) atomicAdd(SS + row, ss);
        }
    }
};
struct EpiUp {
    __device__ __forceinline__ bool reset_after(const Unit&) const { return true; }
    const float* SS; const float* cw; const float* cb; bf16_t* ACT; float* UB;
    __device__ __forceinline__ void operator()(const Acc& acc, const Unit& u, int wr, int wc, int fr, int fq) const {
        const int T0 = u.pm * 256 + wr * 128 + fr * 8, grp = u.pm * 2 + wr, ch0 = u.pn * 128 + wc * 32 + fq * 8;
        const f32x4 sA = *(const f32x4*)(SS + T0), sB = *(const f32x4*)(SS + T0 + 4);
        const float r0 = rsqrtf(sA[0] * (1.f / 1024.f) + EPS), r1 = rsqrtf(sA[1] * (1.f / 1024.f) + EPS), r2 = rsqrtf(sA[2] * (1.f / 1024.f) + EPS), r3 = rsqrtf(sA[3] * (1.f / 1024.f) + EPS);
        const float r4 = rsqrtf(sB[0] * (1.f / 1024.f) + EPS), r5 = rsqrtf(sB[1] * (1.f / 1024.f) + EPS), r6 = rsqrtf(sB[2] * (1.f / 1024.f) + EPS), r7 = rsqrtf(sB[3] * (1.f / 1024.f) + EPS);
        bf16_t* actp = ACT + (size_t)T0 * DFF + ch0;
        float* ubp = UB + ((size_t)grp * DFF + ch0) * 8 + (fr == 15 ? 4 : 0);
#pragma unroll
        for (int n = 0; n < 2; ++n) {
            f32x4 cwa[3], cwg[3];
#pragma unroll
            for (int k = 0; k < 3; ++k) { cwa[k] = *(const f32x4*)(cw + k * UPN + ch0 + 4 * n); cwg[k] = *(const f32x4*)(cw + k * UPN + DFF + ch0 + 4 * n); }
            const f32x4 cba = *(const f32x4*)(cb + ch0 + 4 * n), cbg = *(const f32x4*)(cb + DFF + ch0 + 4 * n);
            unsigned pk[8][2];
#pragma unroll
            for (int jp = 0; jp < 2; ++jp) {
                float res[2][8];
#pragma unroll
                for (int jj = 0; jj < 2; ++jj) {
                    const int j = 2 * jp + jj;
                    const f32x2 w0 = (f32x2){cwa[0][j], cwg[0][j]}, w1 = (f32x2){cwa[1][j], cwg[1][j]}, w2 = (f32x2){cwa[2][j], cwg[2][j]}, bb = (f32x2){cba[j], cbg[j]};
                    const f32x2 x0 = (f32x2){acc[0][0][0][n][j], acc[0][1][0][n][j]} * r0, x1 = (f32x2){acc[0][0][1][n][j], acc[0][1][1][n][j]} * r1;
                    const f32x2 x2 = (f32x2){acc[0][0][2][n][j], acc[0][1][2][n][j]} * r2, x3 = (f32x2){acc[0][0][3][n][j], acc[0][1][3][n][j]} * r3;
                    const f32x2 x4 = (f32x2){acc[1][0][0][n][j], acc[1][1][0][n][j]} * r4, x5 = (f32x2){acc[1][0][1][n][j], acc[1][1][1][n][j]} * r5;
                    const f32x2 x6 = (f32x2){acc[1][0][2][n][j], acc[1][1][2][n][j]} * r6, x7 = (f32x2){acc[1][0][3][n][j], acc[1][1][3][n][j]} * r7;
                    const f32x2 xm2 = (f32x2){dpp_shr1(x6[0]), dpp_shr1(x6[1])}, xm1 = (f32x2){dpp_shr1(x7[0]), dpp_shr1(x7[1])};
                    if (fr == 0) *(f32x4*)(ubp + (4 * n + j) * 8) = (f32x4){x0[0], x0[1], x1[0], x1[1]};
                    if (fr == 15) *(f32x4*)(ubp + (4 * n + j) * 8) = (f32x4){x6[0], x6[1], x7[0], x7[1]};
#define UPC(r, p2, p1, p0) do { const f32x2 c_ = w0 * (p2) + (w1 * (p1) + (w2 * (p0) + bb)); res[jj][r] = c_[0] * sigmoidf_(c_[0]) * c_[1]; } while (0)
                    UPC(0, xm2, xm1, x0); UPC(1, xm1, x0, x1); UPC(2, x0, x1, x2); UPC(3, x1, x2, x3);
                    UPC(4, x2, x3, x4); UPC(5, x3, x4, x5); UPC(6, x4, x5, x6); UPC(7, x5, x6, x7);
#undef UPC
                }
#pragma unroll
                for (int r = 0; r < 8; ++r) pk[r][jp] = cvtpk(res[0][r], res[1][r]);
            }
#pragma unroll
            for (int r = 0; r < 8; ++r) {
                if (fr == 0 && r < 2) continue;
                *(u32x2*)(actp + (size_t)r * DFF + 4 * n) = (u32x2){pk[r][0], pk[r][1]};
            }
        }
    }
};
struct EpiDown {
    __device__ __forceinline__ bool reset_after(const Unit&) const { return true; }
    float* OUT; const bf16_t* X1B;
    __device__ __forceinline__ void operator()(const Acc& acc, const Unit& u, int wr, int wc, int fr, int fq) const {
        const int row0 = u.pm * 256 + wr * 64 + fr, col = u.pn * 256 + wc * 64 + fq * 16;
        u32x4 t[8][2];
#pragma unroll
        for (int i = 0; i < 8; ++i) { const size_t off = (size_t)(row0 + (i >> 2) * 128 + (i & 3) * 16) * DM + col; t[i][0] = *(const u32x4*)(X1B + off); t[i][1] = *(const u32x4*)(X1B + off + 8); }
        asm volatile("" ::: "memory");
#pragma unroll
        for (int ai = 0; ai < 2; ++ai)
#pragma unroll
            for (int m = 0; m < 4; ++m) {
                const size_t off = (size_t)(row0 + ai * 128 + m * 16) * DM + col;
                float* op = OUT + off;
#pragma unroll
                for (int bj = 0; bj < 2; ++bj) {
                    const u32x4 tw = t[ai * 4 + m][bj];
                    f32x4 v0 = acc[ai][bj][m][0], v1 = acc[ai][bj][m][1];
                    v0[0] += bflo(tw.x); v0[1] += bfhi(tw.x); v0[2] += bflo(tw.y); v0[3] += bfhi(tw.y);
                    v1[0] += bflo(tw.z); v1[1] += bfhi(tw.z); v1[2] += bflo(tw.w); v1[3] += bfhi(tw.w);
                    *(f32x4*)(op + 8 * bj) = v0; *(f32x4*)(op + 8 * bj + 4) = v1; }
            }
    }
};

struct AttnP {
    const bf16_t* QK; const bf16_t* VT; const bf16_t* MK; const bf16_t* MVT; const float* C2; bf16_t* O; float* S0;
    const float* lq1; const float* lk1; const float* lq2; const float* lk2; const float* subln; const float* mqn; const float* mkn; const float* GN;
};
__device__ __forceinline__ float max3f_(float a, float b, float c) { float r; asm("v_max3_f32 %0, %1, %2, %3" : "=v"(r) : "v"(a), "v"(b), "v"(c)); return r; }
constexpr int AT_KOFF = 0, AT_VOFF = 17408, AT_COFF = 35840, AT_BUF = 36096, AT_UNITW = 3 * AT_BUF;

template <int KIND>
__device__ __forceinline__ void attn_unit(LAS unsigned char* lds, const AttnP& P, int b, int head, int qb) {
    constexpr int DK = KIND == 2 ? 128 : 64, DV = KIND == 1 ? 64 : 128, NST = DK / 16, NDB = DV / 32;
    constexpr int KPITCH = DK * 2 + 16, VPITCH = 144;
    constexpr int NPASS = KIND == 0 ? 2 : 1;
    constexpr int KLD = DK / 64, VLD = DV / 64;
    int tid = threadIdx.x; asm volatile("" : "+v"(tid));
    const int lane = tid & 63, wid = __builtin_amdgcn_readfirstlane(tid >> 6), r32 = lane & 31, h = lane >> 5;
    const int q0 = qb * 256, qrow = q0 + wid * 32 + r32;
    const size_t tok0 = (size_t)b * SEQ;
    const int nkt = KIND == 2 ? 4 : (q0 + 256) / 64;
    const int wlast = KIND == 2 ? 3 : (q0 + wid * 32) / 64;
    float lam = 0.f;
    if (KIND == 0) {
        float v1 = P.lq1[lane] * P.lk1[lane], v2 = P.lq2[lane] * P.lk2[lane];
        v1 = wave_sum(v1); v2 = wave_sum(v2);
        lam = __expf(v1) - __expf(v2) + 0.2f;
    }
    const float sl2 = KIND == 0 ? LOG2E * exp2f(-2.f * (float)(head + 1)) : 0.f;
    int nit = nkt, ktw = 0;
    if (KIND == 0) {
        float gq = fabsf(P.GN[lane]), gk = fabsf(P.GN[64 + lane]);
#pragma unroll
        for (int o = 1; o < 64; o <<= 1) { gq = fmaxf(gq, __shfl_xor(gq, o)); gk = fmaxf(gk, __shfl_xor(gk, o)); }
        const float B = 1.03f * 64.f * gq * gk;
        const float dmax = (B + 134.f) / sl2;
        int ktm = (int)ceilf(((float)(q0 - 63) - dmax) * (1.f / 64.f));
        ktm = ktm < 0 ? 0 : ktm;
        nit = __builtin_amdgcn_readfirstlane(nkt - ktm);
        if (nit < 1) nit = 1;
        int kw = (int)ceilf(((float)(q0 + wid * 32 - 63) - dmax) * (1.f / 64.f));
        ktw = __builtin_amdgcn_readfirstlane(kw < 0 ? 0 : kw);
    }
#pragma unroll 1
    for (int pass = 0; pass < NPASS; ++pass) {
        const bf16_t *Qp, *Kp, *VTp; int kpitch, vtpitch;
        if (KIND == 0) { Qp = P.QK + tok0 * QKP + head * 128 + pass * 64; Kp = P.QK + tok0 * QKP + 512 + head * 128 + pass * 64; kpitch = QKP; VTp = P.VT + (size_t)(head * 128) * NTOK + tok0; vtpitch = NTOK; }
        else if (KIND == 1) { Qp = P.QK + tok0 * QKP + 1024 + head * 64; Kp = P.QK + tok0 * QKP + 1536 + head * 64; kpitch = QKP; VTp = P.VT + (size_t)(512 + head * 64) * NTOK + tok0; vtpitch = NTOK; }
        else { Qp = P.QK + tok0 * QKP + 2048 + head * 128; Kp = P.MK + (size_t)(b * NMEM) * 512 + head * 128; kpitch = 512; VTp = P.MVT + (size_t)(head * 128) * NMTOK + b * NMEM; vtpitch = NMTOK; }
        bf16x8 qf[NST];
#pragma unroll
        for (int st = 0; st < NST; ++st) qf[st] = *(const bf16x8*)(Qp + (size_t)qrow * QKP + 16 * st + 8 * h);
        if (KIND == 2) {
            float ss = 0.f;
#pragma unroll
            for (int st = 0; st < NST; ++st)
#pragma unroll
                for (int j = 0; j < 8; ++j) { const float v = bf2f((unsigned short)qf[st][j]); ss += v * v; }
            ss += __shfl_xor(ss, 32);
            const float rs = rsqrtf(ss * (1.f / 128.f) + EPS) * (0.08838834764831845f * LOG2E);
#pragma unroll
            for (int st = 0; st < NST; ++st) {
                const f32x4 g0 = *(const f32x4*)(P.mqn + 16 * st + 8 * h), g1 = *(const f32x4*)(P.mqn + 16 * st + 8 * h + 4);
                u32x4 w;
                w.x = cvtpk(bf2f((unsigned short)qf[st][0]) * rs * g0[0], bf2f((unsigned short)qf[st][1]) * rs * g0[1]);
                w.y = cvtpk(bf2f((unsigned short)qf[st][2]) * rs * g0[2], bf2f((unsigned short)qf[st][3]) * rs * g0[3]);
                w.z = cvtpk(bf2f((unsigned short)qf[st][4]) * rs * g1[0], bf2f((unsigned short)qf[st][5]) * rs * g1[1]);
                w.w = cvtpk(bf2f((unsigned short)qf[st][6]) * rs * g1[2], bf2f((unsigned short)qf[st][7]) * rs * g1[3]);
                qf[st] = __builtin_bit_cast(bf16x8, w);
            }
        }
        float m_ref = 0.f, l_run = 0.f;
        f32x16 oT[NDB];
#pragma unroll
        for (int db = 0; db < NDB; ++db)
#pragma unroll
            for (int r = 0; r < 16; ++r) oT[db][r] = 0.f;
        u32x4 kreg[KLD], vreg[VLD]; float creg = 0.f;
#define AT_LOAD(kt) do { const int k0_ = (kt) * 64; \
        _Pragma("unroll") for (int i = 0; i < KLD; ++i) { const int idx = tid + 512 * i, row = idx / (DK / 8), chn = idx % (DK / 8); kreg[i] = *(const u32x4*)(Kp + (size_t)(k0_ + row) * kpitch + chn * 8); } \
        _Pragma("unroll") for (int i = 0; i < VLD; ++i) { const int idx = tid + 512 * i, row = idx >> 3, chn = idx & 7; vreg[i] = *(const u32x4*)(VTp + (size_t)row * vtpitch + k0_ + chn * 8); } \
        if (KIND == 1 && tid < 64) creg = P.C2[(size_t)(b * 8 + head) * SEQ + k0_ + tid]; } while (0)
#define AT_STORE(bufi) do { LAS unsigned char* bb = lds + (bufi) * AT_BUF; \
        _Pragma("unroll") for (int i = 0; i < KLD; ++i) { const int idx = tid + 512 * i, row = idx / (DK / 8), chn = idx % (DK / 8); u32x4 kv = kreg[i]; \
            if (KIND == 2) { float f[8]; f[0] = bflo(kv.x); f[1] = bfhi(kv.x); f[2] = bflo(kv.y); f[3] = bfhi(kv.y); f[4] = bflo(kv.z); f[5] = bfhi(kv.z); f[6] = bflo(kv.w); f[7] = bfhi(kv.w); \
                float ss = 0.f; _Pragma("unroll") for (int e = 0; e < 8; ++e) ss += f[e] * f[e]; \
                ss = row16_sum(ss); \
                const float rs = rsqrtf(ss * (1.f / 128.f) + EPS); const f32x4 g0 = *(const f32x4*)(P.mkn + chn * 8), g1 = *(const f32x4*)(P.mkn + chn * 8 + 4); \
                kv.x = cvtpk(f[0] * rs * g0[0], f[1] * rs * g0[1]); kv.y = cvtpk(f[2] * rs * g0[2], f[3] * rs * g0[3]); kv.z = cvtpk(f[4] * rs * g1[0], f[5] * rs * g1[1]); kv.w = cvtpk(f[6] * rs * g1[2], f[7] * rs * g1[3]); } \
            *(LAS u32x4*)(bb + AT_KOFF + row * KPITCH + chn * 16) = kv; } \
        _Pragma("unroll") for (int i = 0; i < VLD; ++i) { const int idx = tid + 512 * i, row = idx >> 3, chn = idx & 7; LAS unsigned char* vp_ = bb + AT_VOFF + row * VPITCH + (chn >> 1) * 32 + (chn & 1) * 8; \
            *(LAS u32x2*)vp_ = (u32x2){vreg[i].x, vreg[i].y}; *(LAS u32x2*)(vp_ + 16) = (u32x2){vreg[i].z, vreg[i].w}; } \
        if (KIND == 1 && tid < 64) *(LAS float*)(bb + AT_COFF + tid * 4) = creg; } while (0)
        AT_LOAD(nkt - 1); AT_STORE(0);
        __syncthreads();
#define AT_PV(bufp) do { const LAS unsigned char* vb_ = (bufp) + AT_VOFF + r32 * VPITCH + h * 16; \
        _Pragma("unroll") for (int dp = 0; dp < NDB / 2; ++dp) { bf16x8 va[2][4]; \
            _Pragma("unroll") for (int d2 = 0; d2 < 2; ++d2) _Pragma("unroll") for (int kk = 0; kk < 4; ++kk) va[d2][kk] = *(const LAS bf16x8*)(vb_ + (2 * dp + d2) * 32 * VPITCH + kk * 32); \
            __builtin_amdgcn_sched_barrier(0); \
            _Pragma("unroll") for (int kk = 0; kk < 4; ++kk) _Pragma("unroll") for (int d2 = 0; d2 < 2; ++d2) oT[2 * dp + d2] = __builtin_amdgcn_mfma_f32_32x32x16_bf16(va[d2][kk], pf[kk], oT[2 * dp + d2], 0, 0, 0); \
            __builtin_amdgcn_sched_barrier(0); } } while (0)
        const bool lateB = false;
        bool have_prev = false; int prev_buf = 0, bi = 0;
        bf16x8 pf[4];
#pragma unroll
        for (int i = 0; i < 4; ++i) pf[i] = (bf16x8){0, 0, 0, 0, 0, 0, 0, 0};
#pragma unroll 1
        for (int it = 0; it < nit; ++it) {
            const int kt = nkt - 1 - it;
            if (it + 1 < nit) AT_LOAD(kt - 1);
            if (lateB && have_prev) { AT_PV(lds + prev_buf * AT_BUF); }
            if (kt <= wlast && kt >= ktw) {
                const LAS unsigned char* buf = lds + bi * AT_BUF;
                const int k0 = kt * 64;
                f32x16 s0, s1;
                if (KIND == 0 && kt < wlast) {
                    const float nb = -m_ref - sl2 * (float)(qrow - k0 - 4 * h);
#pragma unroll
                    for (int r = 0; r < 16; ++r) { const float o = (float)((r & 3) + 8 * (r >> 2)); s0[r] = fmaf(sl2, o, nb); s1[r] = fmaf(sl2, o + 32.f, nb); }
                } else if (KIND == 1) {
                    const LAS float* cs = (const LAS float*)(buf + AT_COFF);
#pragma unroll
                    for (int g = 0; g < 4; ++g) { const f32x4 c0 = *(const LAS f32x4*)(cs + 8 * g + 4 * h), c1 = *(const LAS f32x4*)(cs + 32 + 8 * g + 4 * h);
#pragma unroll
                        for (int i = 0; i < 4; ++i) { s0[4 * g + i] = -m_ref - c0[i]; s1[4 * g + i] = -m_ref - c1[i]; } }
                } else {
#pragma unroll
                    for (int r = 0; r < 16; ++r) { s0[r] = -m_ref; s1[r] = -m_ref; }
                }
                const LAS unsigned char* kb_ = buf + AT_KOFF + r32 * KPITCH + h * 16;
#pragma unroll
                for (int sg = 0; sg < NST / 4; ++sg) {
                    bf16x8 ka[4][2];
#pragma unroll
                    for (int st = 0; st < 4; ++st) { ka[st][0] = *(const LAS bf16x8*)(kb_ + (4 * sg + st) * 32); ka[st][1] = *(const LAS bf16x8*)(kb_ + 32 * KPITCH + (4 * sg + st) * 32); }
                    __builtin_amdgcn_sched_barrier(0);
#pragma unroll
                    for (int st = 0; st < 4; ++st) {
                        s0 = __builtin_amdgcn_mfma_f32_32x32x16_bf16(ka[st][0], qf[4 * sg + st], s0, 0, 0, 0);
                        s1 = __builtin_amdgcn_mfma_f32_32x32x16_bf16(ka[st][1], qf[4 * sg + st], s1, 0, 0, 0);
                    }
                    __builtin_amdgcn_sched_barrier(0);
                }
                if (KIND == 1) {
                    if (kt == wlast) {
#pragma unroll
                        for (int r = 0; r < 16; ++r) { const int kv = k0 + (r & 3) + 8 * (r >> 2) + 4 * h; if (kv > qrow) s0[r] = -INFINITY; if (kv + 32 > qrow) s1[r] = -INFINITY; }
                    }
                }
                if (KIND == 0 && kt == wlast) {
                    const float dq = (float)(qrow - k0 - 4 * h);
#pragma unroll
                    for (int r = 0; r < 16; ++r) { const float o = (float)((r & 3) + 8 * (r >> 2)); s0[r] = fmaf(-sl2, fabsf(dq - o), s0[r]); s1[r] = fmaf(-sl2, fabsf(dq - o - 32.f), s1[r]); }
                }
                float mx = max3f_(s0[0], s1[0], s0[1]), mxb = max3f_(s1[1], s0[2], s1[2]);
#pragma unroll
                for (int r = 3; r < 15; r += 2) { mx = max3f_(mx, s0[r], s1[r]); mxb = max3f_(mxb, s0[r + 1], s1[r + 1]); }
                mx = max3f_(mx, s0[15], s1[15]); mx = max3f_(mx, mxb, mxb);
                { const auto rr = __builtin_amdgcn_permlane32_swap(__float_as_uint(mx), __float_as_uint(mx), false, false); mx = max3f_(__uint_as_float(rr[0]), __uint_as_float(rr[1]), __uint_as_float(rr[1])); }
                if (!(KIND == 0 && __all(mx < -134.f))) {
                if (__any(mx > 8.f)) {
                    const float dl = fmaxf(mx, 0.f), f = fast_exp2(-dl);
                    m_ref += dl; l_run *= f;
#pragma unroll
                    for (int r = 0; r < 16; ++r) { s0[r] -= dl; s1[r] -= dl; }
#pragma unroll
                    for (int db = 0; db < NDB; ++db)
#pragma unroll
                        for (int r = 0; r < 16; ++r) oT[db][r] *= f;
                }
                const LAS unsigned char* vb0_ = buf + AT_VOFF + r32 * VPITCH + h * 16;
                bf16x8 va0[2][4];
#pragma unroll
                for (int d2 = 0; d2 < 2; ++d2)
#pragma unroll
                    for (int kk = 0; kk < 4; ++kk) va0[d2][kk] = *(const LAS bf16x8*)(vb0_ + d2 * 32 * VPITCH + kk * 32);
                __builtin_amdgcn_sched_barrier(0);
                f32x2 rs2 = (f32x2){0.f, 0.f};
#pragma unroll
                for (int r = 0; r < 16; ++r) { s0[r] = fast_exp2(s0[r]); s1[r] = fast_exp2(s1[r]); }
#pragma unroll
                for (int r = 0; r < 16; r += 2) { rs2 += (f32x2){s0[r], s0[r + 1]}; rs2 += (f32x2){s1[r], s1[r + 1]}; }
                l_run += rs2[0] + rs2[1];
                { u32x4 w;
                  w.x = cvtpk(s0[0], s0[1]); w.y = cvtpk(s0[2], s0[3]); w.z = cvtpk(s0[4], s0[5]); w.w = cvtpk(s0[6], s0[7]); pf[0] = __builtin_bit_cast(bf16x8, w);
                  w.x = cvtpk(s0[8], s0[9]); w.y = cvtpk(s0[10], s0[11]); w.z = cvtpk(s0[12], s0[13]); w.w = cvtpk(s0[14], s0[15]); pf[1] = __builtin_bit_cast(bf16x8, w);
                  w.x = cvtpk(s1[0], s1[1]); w.y = cvtpk(s1[2], s1[3]); w.z = cvtpk(s1[4], s1[5]); w.w = cvtpk(s1[6], s1[7]); pf[2] = __builtin_bit_cast(bf16x8, w);
                  w.x = cvtpk(s1[8], s1[9]); w.y = cvtpk(s1[10], s1[11]); w.z = cvtpk(s1[12], s1[13]); w.w = cvtpk(s1[14], s1[15]); pf[3] = __builtin_bit_cast(bf16x8, w); }
                __builtin_amdgcn_sched_barrier(0);
#pragma unroll
                for (int kk = 0; kk < 4; ++kk)
#pragma unroll
                    for (int d2 = 0; d2 < 2; ++d2) oT[d2] = __builtin_amdgcn_mfma_f32_32x32x16_bf16(va0[d2][kk], pf[kk], oT[d2], 0, 0, 0);
                __builtin_amdgcn_sched_barrier(0);
                if (NDB == 4) {
                    bf16x8 va1[2][4];
#pragma unroll
                    for (int d2 = 0; d2 < 2; ++d2)
#pragma unroll
                        for (int kk = 0; kk < 4; ++kk) va1[d2][kk] = *(const LAS bf16x8*)(vb0_ + (2 + d2) * 32 * VPITCH + kk * 32);
                    __builtin_amdgcn_sched_barrier(0);
#pragma unroll
                    for (int kk = 0; kk < 4; ++kk)
#pragma unroll
                        for (int d2 = 0; d2 < 2; ++d2) oT[NDB - 2 + d2] = __builtin_amdgcn_mfma_f32_32x32x16_bf16(va1[d2][kk], pf[kk], oT[NDB - 2 + d2], 0, 0, 0);
                    __builtin_amdgcn_sched_barrier(0);
                }
                }
            }
            if (lateB) { have_prev = (kt <= wlast); prev_buf = bi; }
            const int bn = bi == 2 ? 0 : bi + 1;
            if (it + 1 < nit) AT_STORE(bn);
            bi = bn;
            __syncthreads();
        }
        if (lateB && have_prev) { AT_PV(lds + prev_buf * AT_BUF); }
        __syncthreads();
#undef AT_PV
#undef AT_LOAD
#undef AT_STORE
        const float l = l_run + __shfl_xor(l_run, 32), inv = 1.f / l;
        float* sp = P.S0 + (tok0 + qrow) * 512 + head * 128 + 4 * h;
        if (KIND == 0 && pass == 0) {
#pragma unroll
            for (int db = 0; db < NDB; ++db)
#pragma unroll
                for (int g = 0; g < 4; ++g) { f32x4 v; v[0] = oT[db][4 * g] * inv; v[1] = oT[db][4 * g + 1] * inv; v[2] = oT[db][4 * g + 2] * inv; v[3] = oT[db][4 * g + 3] * inv; *(f32x4*)(sp + 32 * db + 8 * g) = v; }
        } else {
            float rs = inv;
            if (KIND == 0) {
                float ss = 0.f; const float li = lam * inv;
#pragma unroll
                for (int db = 0; db < NDB; ++db)
#pragma unroll
                    for (int g = 0; g < 4; ++g) { const f32x4 o0 = *(const f32x4*)(sp + 32 * db + 8 * g);
#pragma unroll
                        for (int i = 0; i < 4; ++i) { const float v = o0[i] - li * oT[db][4 * g + i]; oT[db][4 * g + i] = v; ss += v * v; } }
                ss += __shfl_xor(ss, 32);
                rs = rsqrtf(ss * (1.f / 128.f) + EPS) * 0.8f;
            }
            const int obase = KIND == 0 ? 0 : (KIND == 1 ? 1 : 2);
            bf16_t* op = P.O + (size_t)obase * NTOK * 512 + (tok0 + qrow) * 512 + head * DV + 4 * h;
#pragma unroll
            for (int db = 0; db < NDB; ++db)
#pragma unroll
                for (int g = 0; g < 4; ++g) {
                    f32x4 mu = (f32x4){rs, rs, rs, rs};
                    if (KIND == 0) mu = mu * *(const f32x4*)(P.subln + 32 * db + 8 * g + 4 * h);
                    u32x2 w; w.x = cvtpk(oT[db][4 * g] * mu[0], oT[db][4 * g + 1] * mu[1]); w.y = cvtpk(oT[db][4 * g + 2] * mu[2], oT[db][4 * g + 3] * mu[3]);
                    *(u32x2*)(op + 32 * db + 8 * g) = w; }
        }
    }
}

__device__ __forceinline__ void attn_fx64(LAS unsigned char* lds, const AttnP& P, int b, int head, int qb) {
    constexpr int KPITCH = 144, VPITCH = 144;
    int tid = threadIdx.x; asm volatile("" : "+v"(tid));
    const int lane = tid & 63, wid = __builtin_amdgcn_readfirstlane(tid >> 6), r32 = lane & 31, h = lane >> 5;
    const int q0 = qb * 512, qA = q0 + wid * 64 + r32, qB = qA + 32;
    const size_t tok0 = (size_t)b * SEQ;
    const int nkt = (q0 + 512) / 64, wlast = (q0 >> 6) + wid;
    const bf16_t* Qp = P.QK + tok0 * QKP + 1024 + head * 64;
    const bf16_t* Kp = P.QK + tok0 * QKP + 1536 + head * 64;
    const bf16_t* VTp = P.VT + (size_t)(512 + head * 64) * NTOK + tok0;
    const float* C2p = P.C2 + (size_t)(b * 8 + head) * SEQ;
    bf16x8 qfA[4], qfB[4];
#pragma unroll
    for (int st = 0; st < 4; ++st) { qfA[st] = *(const bf16x8*)(Qp + (size_t)qA * QKP + 16 * st + 8 * h); qfB[st] = *(const bf16x8*)(Qp + (size_t)qB * QKP + 16 * st + 8 * h); }
    float mA = 0.f, mB = 0.f, lA = 0.f, lB = 0.f;
    f32x16 oA[2], oB[2];
#pragma unroll
    for (int d = 0; d < 2; ++d)
#pragma unroll
        for (int r = 0; r < 16; ++r) { oA[d][r] = 0.f; oB[d][r] = 0.f; }
    u32x4 kreg, vreg; float creg = 0.f;
    const int srow = tid >> 3, schn = tid & 7;
#define FX_LOAD(kt) do { const int k0_ = (kt) * 64; kreg = *(const u32x4*)(Kp + (size_t)(k0_ + srow) * QKP + schn * 8); vreg = *(const u32x4*)(VTp + (size_t)srow * NTOK + k0_ + schn * 8); \
        if (tid < 64) creg = C2p[k0_ + tid]; } while (0)
#define FX_STORE(bufi) do { LAS unsigned char* bb = lds + (bufi) * AT_BUF; *(LAS u32x4*)(bb + AT_KOFF + srow * KPITCH + schn * 16) = kreg; \
        LAS unsigned char* vp_ = bb + AT_VOFF + srow * VPITCH + (schn >> 1) * 32 + (schn & 1) * 8; *(LAS u32x2*)vp_ = (u32x2){vreg.x, vreg.y}; *(LAS u32x2*)(vp_ + 16) = (u32x2){vreg.z, vreg.w}; \
        if (tid < 64) *(LAS float*)(bb + AT_COFF + tid * 4) = creg; } while (0)
#define FX_MAX(MX, S0, S1) do { float m_ = max3f_(S0[0], S1[0], S0[1]), n_ = max3f_(S1[1], S0[2], S1[2]); \
        _Pragma("unroll") for (int r = 3; r < 15; r += 2) { m_ = max3f_(m_, S0[r], S1[r]); n_ = max3f_(n_, S0[r + 1], S1[r + 1]); } \
        m_ = max3f_(m_, S0[15], S1[15]); m_ = max3f_(m_, n_, n_); \
        const auto rr_ = __builtin_amdgcn_permlane32_swap(__float_as_uint(m_), __float_as_uint(m_), false, false); MX = max3f_(__uint_as_float(rr_[0]), __uint_as_float(rr_[1]), __uint_as_float(rr_[1])); } while (0)
#define FX_EXP(S0, S1, L, PF) do { f32x2 rs2 = (f32x2){0.f, 0.f}; \
        _Pragma("unroll") for (int r = 0; r < 16; ++r) { S0[r] = fast_exp2(S0[r]); S1[r] = fast_exp2(S1[r]); } \
        _Pragma("unroll") for (int r = 0; r < 16; r += 2) { rs2 += (f32x2){S0[r], S0[r + 1]}; rs2 += (f32x2){S1[r], S1[r + 1]}; } \
        L += rs2[0] + rs2[1]; u32x4 w; \
        w.x = cvtpk(S0[0], S0[1]); w.y = cvtpk(S0[2], S0[3]); w.z = cvtpk(S0[4], S0[5]); w.w = cvtpk(S0[6], S0[7]); PF[0] = __builtin_bit_cast(bf16x8, w); \
        w.x = cvtpk(S0[8], S0[9]); w.y = cvtpk(S0[10], S0[11]); w.z = cvtpk(S0[12], S0[13]); w.w = cvtpk(S0[14], S0[15]); PF[1] = __builtin_bit_cast(bf16x8, w); \
        w.x = cvtpk(S1[0], S1[1]); w.y = cvtpk(S1[2], S1[3]); w.z = cvtpk(S1[4], S1[5]); w.w = cvtpk(S1[6], S1[7]); PF[2] = __builtin_bit_cast(bf16x8, w); \
        w.x = cvtpk(S1[8], S1[9]); w.y = cvtpk(S1[10], S1[11]); w.z = cvtpk(S1[12], S1[13]); w.w = cvtpk(S1[14], S1[15]); PF[3] = __builtin_bit_cast(bf16x8, w); } while (0)
    FX_LOAD(nkt - 1); FX_STORE(0);
    __syncthreads();
#pragma unroll 1
    for (int it = 0; it < nkt; ++it) {
        const int kt = nkt - 1 - it;
        if (it + 1 < nkt) FX_LOAD(kt - 1);
        if (kt <= wlast) {
            const LAS unsigned char* buf = lds + (it & 1) * AT_BUF;
            const int k0 = kt * 64;
            f32x16 a0, a1, b0, b1;
            {
                const LAS float* cs = (const LAS float*)(buf + AT_COFF);
#pragma unroll
                for (int g = 0; g < 4; ++g) { const f32x4 c0 = *(const LAS f32x4*)(cs + 8 * g + 4 * h), c1 = *(const LAS f32x4*)(cs + 32 + 8 * g + 4 * h);
#pragma unroll
                    for (int i = 0; i < 4; ++i) { a0[4 * g + i] = -mA - c0[i]; a1[4 * g + i] = -mA - c1[i]; b0[4 * g + i] = -mB - c0[i]; b1[4 * g + i] = -mB - c1[i]; } }
            }
            {
                const LAS unsigned char* kb_ = buf + AT_KOFF + r32 * KPITCH + h * 16;
                bf16x8 ka[4][2];
#pragma unroll
                for (int st = 0; st < 4; ++st) { ka[st][0] = *(const LAS bf16x8*)(kb_ + st * 32); ka[st][1] = *(const LAS bf16x8*)(kb_ + 32 * KPITCH + st * 32); }
                __builtin_amdgcn_sched_barrier(0);
#pragma unroll
                for (int st = 0; st < 4; ++st) {
                    a0 = __builtin_amdgcn_mfma_f32_32x32x16_bf16(ka[st][0], qfA[st], a0, 0, 0, 0);
                    b0 = __builtin_amdgcn_mfma_f32_32x32x16_bf16(ka[st][0], qfB[st], b0, 0, 0, 0);
                    a1 = __builtin_amdgcn_mfma_f32_32x32x16_bf16(ka[st][1], qfA[st], a1, 0, 0, 0);
                    b1 = __builtin_amdgcn_mfma_f32_32x32x16_bf16(ka[st][1], qfB[st], b1, 0, 0, 0);
                }
                __builtin_amdgcn_sched_barrier(0);
            }
            if (kt == wlast) {
#pragma unroll
                for (int r = 0; r < 16; ++r) { const int kv = k0 + (r & 3) + 8 * (r >> 2) + 4 * h;
                    if (kv > qA) a0[r] = -INFINITY; if (kv + 32 > qA) a1[r] = -INFINITY; if (kv > qB) b0[r] = -INFINITY; if (kv + 32 > qB) b1[r] = -INFINITY; }
            }
            float mxA, mxB; FX_MAX(mxA, a0, a1); FX_MAX(mxB, b0, b1);
            if (!__all(fmaxf(mxA, mxB) < -134.f)) {
            if (__any(fmaxf(mxA, mxB) > 8.f)) {
                const float dA = fmaxf(mxA, 0.f), dB = fmaxf(mxB, 0.f), fA = fast_exp2(-dA), fB = fast_exp2(-dB);
                mA += dA; mB += dB; lA *= fA; lB *= fB;
#pragma unroll
                for (int r = 0; r < 16; ++r) { a0[r] -= dA; a1[r] -= dA; b0[r] -= dB; b1[r] -= dB; }
#pragma unroll
                for (int d = 0; d < 2; ++d)
#pragma unroll
                    for (int r = 0; r < 16; ++r) { oA[d][r] *= fA; oB[d][r] *= fB; }
            }
            const LAS unsigned char* vb_ = buf + AT_VOFF + r32 * VPITCH + h * 16;
            bf16x8 va[2][4];
#pragma unroll
            for (int d2 = 0; d2 < 2; ++d2)
#pragma unroll
                for (int kk = 0; kk < 4; ++kk) va[d2][kk] = *(const LAS bf16x8*)(vb_ + d2 * 32 * VPITCH + kk * 32);
            __builtin_amdgcn_sched_barrier(0);
            bf16x8 pA[4], pB[4];
            FX_EXP(a0, a1, lA, pA);
            __builtin_amdgcn_sched_barrier(0);
#pragma unroll
            for (int kk = 0; kk < 4; ++kk)
#pragma unroll
                for (int d2 = 0; d2 < 2; ++d2) oA[d2] = __builtin_amdgcn_mfma_f32_32x32x16_bf16(va[d2][kk], pA[kk], oA[d2], 0, 0, 0);
            __builtin_amdgcn_sched_barrier(0);
            FX_EXP(b0, b1, lB, pB);
            __builtin_amdgcn_sched_barrier(0);
#pragma unroll
            for (int kk = 0; kk < 4; ++kk)
#pragma unroll
                for (int d2 = 0; d2 < 2; ++d2) oB[d2] = __builtin_amdgcn_mfma_f32_32x32x16_bf16(va[d2][kk], pB[kk], oB[d2], 0, 0, 0);
            __builtin_amdgcn_sched_barrier(0);
            }
        }
        if (it + 1 < nkt) FX_STORE((it + 1) & 1);
        __syncthreads();
    }
#undef FX_LOAD
#undef FX_STORE
#undef FX_MAX
#undef FX_EXP
    const float iA = 1.f / (lA + __shfl_xor(lA, 32)), iB = 1.f / (lB + __shfl_xor(lB, 32));
    bf16_t* opA = P.O + (size_t)NTOK * 512 + (tok0 + qA) * 512 + head * 64 + 4 * h;
    bf16_t* opB = opA + (size_t)32 * 512;
#pragma unroll
    for (int db = 0; db < 2; ++db)
#pragma unroll
        for (int g = 0; g < 4; ++g) {
            u32x2 w; w.x = cvtpk(oA[db][4 * g] * iA, oA[db][4 * g + 1] * iA); w.y = cvtpk(oA[db][4 * g + 2] * iA, oA[db][4 * g + 3] * iA); *(u32x2*)(opA + 32 * db + 8 * g) = w;
            u32x2 x; x.x = cvtpk(oB[db][4 * g] * iB, oB[db][4 * g + 1] * iB); x.y = cvtpk(oB[db][4 * g + 2] * iB, oB[db][4 * g + 3] * iB); *(u32x2*)(opB + 32 * db + 8 * g) = x; }
}

__device__ __forceinline__ void decode_unit(int idx, int& kind, int& qb, int& sub) {
    if (idx < 320) { kind = 0; qb = 7 - idx / 64; sub = idx % 64; }
    else if (idx < 448) { kind = 1; qb = 3; sub = idx - 320; }
    else if (idx < 512) { kind = 0; qb = 2; sub = idx - 448; }
    else if (idx < 640) { kind = 1; qb = 2; sub = idx - 512; }
    else if (idx < 704) { kind = 0; qb = 1; sub = idx - 640; }
    else if (idx < 832) { kind = 1; qb = 1; sub = idx - 704; }
    else if (idx < 896) { kind = 0; qb = 0; sub = idx - 832; }
    else if (idx < 1024) { kind = 1; qb = 0; sub = idx - 896; }
    else { kind = 2; const int t = idx - 1024; qb = t / 64; sub = t % 64; }
}
constexpr int N_ATT_UNITS = 1536;

__device__ __forceinline__ int inv_perm16(int L) { return ((L >> 3) & 1) * 128 + (L >> 6) * 32 + ((L >> 2) & 1) * 16 + ((L >> 4) & 3) * 4 + (L & 3); }
__device__ __forceinline__ int src_of(int mat, int lg) {
    switch (mat) {
    case 0: if (lg < 1024) return lg; if (lg < 2048) return 1536 + (lg - 1024); if (lg < 2560) return 3080 + (lg - 2048); return 3592 + (lg - 2560);
    case 1: return lg < 512 ? 1024 + lg : 2560 + (lg - 512);
    case 3: return 512 + lg;
    default: return lg;
    }
}
__device__ __forceinline__ int dst_of(int mat, int lg) {
    switch (mat) {
    case 1: case 3: return lg;
    case 8: { const int bj = lg >= DFF ? 1 : 0, chl = lg - bj * DFF, pn = chl >> 7, co = chl & 127;
              return pn * 256 + bj * 128 + (co >> 5) * 32 + ((co >> 2) & 1) * 16 + ((co >> 3) & 3) * 4 + (co & 3); }
    default: return (lg & ~255) + inv_perm16(lg & 255);
    }
}
__device__ __forceinline__ void transpose_item(const float* W, int K, int Npitch, bf16_t* WT, int nblk, int mat, const float* rowgain, LAS float* scr, int item, int lane) {
    const int kb = item / nblk, nb = item % nblk, k0 = 64 * kb, l0 = 32 * nb;
    const int sc = src_of(mat, l0 + (lane & 31));
    float t[32];
#pragma unroll
    for (int i = 0; i < 32; ++i) t[i] = W[(size_t)(k0 + 2 * i + (lane >> 5)) * Npitch + sc];
#pragma unroll
    for (int i = 0; i < 32; ++i) { const int kk = 2 * i + (lane >> 5); float v = t[i]; if (rowgain) v *= rowgain[k0 + kk]; scr[kk * 33 + (lane & 31)] = v; }
    asm volatile("s_waitcnt lgkmcnt(0)" ::: "memory");
    const int c = lane & 7;
#pragma unroll
    for (int j = 0; j < 4; ++j) { const int n = (lane >> 3) + 8 * j; const LAS float* sp = scr + (8 * c) * 33 + n;
        u32x4 o; o.x = cvtpk(sp[0 * 33], sp[1 * 33]); o.y = cvtpk(sp[2 * 33], sp[3 * 33]); o.z = cvtpk(sp[4 * 33], sp[5 * 33]); o.w = cvtpk(sp[6 * 33], sp[7 * 33]);
        *(u32x4*)(WT + (size_t)dst_of(mat, l0 + n) * K + k0 + 8 * c) = o; }
    asm volatile("s_waitcnt lgkmcnt(0)" ::: "memory");
}

#define XB_TMO      128
#define XB_XCNT(j)  (256  + 64 * (j))
#define XB_XSUB(j)  (1280 + 64 * (j))
#define XB_XGEN(j)  (2304 + 64 * (j))
#define XB_TOP      3328
#define XB_TOPGEN   3392
#define XCD_BAR_WORDS 3456
#define XB_SPIN_CAP (1u << 22)
__device__ __forceinline__ unsigned xb_ld(unsigned* p)              { return __hip_atomic_load(p, __ATOMIC_RELAXED, __HIP_MEMORY_SCOPE_AGENT); }
__device__ __forceinline__ unsigned xb_add(unsigned* p, unsigned v) { return __hip_atomic_fetch_add(p, v, __ATOMIC_RELAXED, __HIP_MEMORY_SCOPE_AGENT); }
__device__ __forceinline__ unsigned xb_xcc_id() { return (unsigned)__builtin_amdgcn_s_getreg((3 << 11) | 20) & 0xFu; }
#define XB_SPIN(cond, bar) do { unsigned _sp = 0; while (cond) { __builtin_amdgcn_s_sleep(1); \
    if ((++_sp & 255u) == 0u) { if (xb_ld(&(bar)[XB_TMO])) break; if (_sp > XB_SPIN_CAP) { atomicAdd(&(bar)[XB_TMO], 1u); break; } } } } while (0)
struct XcdBarrier { unsigned* bar; unsigned x; volatile LAS unsigned* st; };
__device__ __forceinline__ XcdBarrier xcd_barrier_post(unsigned* bar, volatile LAS unsigned* st) {
    XcdBarrier b; b.bar = bar; b.x = xb_xcc_id(); b.st = st;
    if (threadIdx.x == 0) (void)xb_add(&bar[XB_XCNT(b.x)], 1u);
    return b;
}
__device__ __forceinline__ void xcd_barrier_complete(unsigned* bar, unsigned x, unsigned& nloc, unsigned& nx) {
    const unsigned G = gridDim.x * gridDim.y * gridDim.z;
    unsigned sum, cnt, mine, sp = 0u;
    for (;;) {
        sum = 0u; cnt = 0u; mine = 0u;
#pragma unroll
        for (unsigned j = 0; j < 16; ++j) { const unsigned c = xb_ld(&bar[XB_XCNT(j)]); sum += c; cnt += (c > 0u) ? 1u : 0u; mine = (j == x) ? c : mine; }
        if (sum == G) break;
        __builtin_amdgcn_s_sleep(1);
        if ((++sp & 255u) == 0u) { if (xb_ld(&bar[XB_TMO])) break; if (sp > XB_SPIN_CAP) { atomicAdd(&bar[XB_TMO], 1u); break; } }
    }
    nloc = mine > 0u ? mine : 1u; nx = cnt > 0u ? cnt : 1u;
}
__device__ __forceinline__ void xcd_barrier(const XcdBarrier& b) {
    asm volatile("s_waitcnt vmcnt(0)" ::: "memory");
    __syncthreads();
    if (threadIdx.x == 0) {
        unsigned* bar = b.bar;
        __builtin_amdgcn_s_waitcnt(0);
        unsigned nloc = b.st[0], nx = b.st[1];
        if (nloc == 0u) { xcd_barrier_complete(bar, b.x, nloc, nx); b.st[0] = nloc; b.st[1] = nx; }
        const unsigned old = xb_add(&bar[XB_XSUB(b.x)], 1u);
        const unsigned gen = old / nloc;
        if (old + 1u == (gen + 1u) * nloc) {
            __builtin_amdgcn_fence(__ATOMIC_RELEASE, "agent");
            asm volatile("s_waitcnt vmcnt(0)" ::: "memory");
            const unsigned og = xb_add(&bar[XB_TOP], 1u);
            const unsigned tg = og / nx;
            if (og + 1u == (tg + 1u) * nx) xb_add(&bar[XB_TOPGEN], 1u);
            else XB_SPIN(xb_ld(&bar[XB_TOPGEN]) == tg, bar);
            __builtin_amdgcn_fence(__ATOMIC_ACQUIRE, "agent");
            xb_add(&bar[XB_XGEN(b.x)], 1u);
            asm volatile("s_waitcnt vmcnt(0)" ::: "memory");
        } else {
            XB_SPIN(xb_ld(&bar[XB_XGEN(b.x)]) == gen, bar);
            __builtin_amdgcn_fence(__ATOMIC_ACQUIRE, "agent");
            asm volatile("s_waitcnt vmcnt(0)" ::: "memory");
        }
    }
    __syncthreads();
}

struct Args { const float* in[28]; float* out; unsigned char* ws; int ph_lo, ph_hi; };

__global__ void __launch_bounds__(512, 2) mega_fwd(Args a) {
    extern __shared__ __attribute__((aligned(16))) unsigned char lds_raw[];
    LAS unsigned char* lds = (LAS unsigned char*)lds_raw;
    const int tid = threadIdx.x, lane = tid & 63, wid = __builtin_amdgcn_readfirstlane(tid >> 6);
    const int G = gridDim.x, bx = blockIdx.x;
    unsigned char* ws = a.ws;
    const int lo = a.ph_lo, hi = a.ph_hi;
#define IN(k) (lo <= (k) && (k) < hi)
#define SYNC_AFTER(k) do { if (IN(k) && IN((k) + 1)) { xcd_barrier(xbar); } } while (0)
    { volatile LAS unsigned* st_ = (volatile LAS unsigned*)(lds + LDS_BYTES - 16); if (tid < 4) st_[tid] = 0u; }
    __syncthreads();
    const XcdBarrier xbar = xcd_barrier_post((unsigned*)(ws + WS_CTL) + 2048, (volatile LAS unsigned*)(lds + LDS_BYTES - 16));
    if (hi > 100) cg::this_grid().sync();
    const float* x = a.in[0];
    bf16_t* H = (bf16_t*)a.out;
    bf16_t* VT = (bf16_t*)((unsigned char*)a.out + 64 * MiB);
    bf16_t* MH = (bf16_t*)(ws + WS_MH);
    float* LOGF = (float*)(ws + WS_LOGF); float* C2 = (float*)(ws + WS_C2); float* SS = (float*)(ws + WS_SS);
    unsigned* CTL = (unsigned*)(ws + WS_CTL);

    if (IN(0)) {
        const int gw = bx * NWAVES + wid, NGW = G * NWAVES;
        LAS float* wl = (LAS float*)lds;
        for (int i = tid; i < 1024 * 8; i += 512) { const int k = i >> 3, g = i & 7; const int j = k >> 8, ln = (k >> 2) & 63, e = k & 3;
            wl[((j * 4 + e) * 64 + ln) * 8 + g] = a.in[3][(size_t)k * INCOLS + 3072 + g]; }
        for (int i = bx * 512 + tid; i < NTOK; i += G * 512) SS[i] = 0.f;
        if (bx == 0 && tid < 64) { float* GN = (float*)(ws + WS_CTL + 4096); const float qs = 0.125f * LOG2E;
            GN[tid] = a.in[5][tid] * qs; GN[64 + tid] = a.in[6][tid]; GN[128 + tid] = a.in[12][tid] * qs; GN[192 + tid] = a.in[13][tid]; }
        __syncthreads();
        LAS float* scr = (LAS float*)(lds + 32768 + wid * 8448);
        constexpr int I0 = 2816, I1 = I0 + 512, I2 = I1 + 256, I3 = I2 + 256, I4 = I3 + 256, I5 = I4 + 256, I6 = I5 + 256, I7 = I6 + 512, I8 = I7 + 2816, I9 = I8 + 1408;
        for (int it = gw; it < I9; it += NGW) {
            if (it < I0) transpose_item(a.in[3], 1024, INCOLS, (bf16_t*)(ws + WS_W1), 176, 0, nullptr, scr, it, lane);
            else if (it < I1) transpose_item(a.in[3], 1024, INCOLS, (bf16_t*)(ws + WS_WV), 32, 1, nullptr, scr, it - I0, lane);
            else if (it < I2) transpose_item(a.in[16], 1024, 1024, (bf16_t*)(ws + WS_WMK), 16, 2, nullptr, scr, it - I1, lane);
            else if (it < I3) transpose_item(a.in[16], 1024, 1024, (bf16_t*)(ws + WS_WMV), 16, 3, nullptr, scr, it - I2, lane);
            else if (it < I4) transpose_item(a.in[19], 512, 1024, (bf16_t*)(ws + WS_WBR), 32, 4, nullptr, scr, it - I3, lane);
            else if (it < I5) transpose_item(a.in[20], 512, 1024, (bf16_t*)(ws + WS_WBR) + 1024 * 512, 32, 4, nullptr, scr, it - I4, lane);
            else if (it < I6) transpose_item(a.in[21], 512, 1024, (bf16_t*)(ws + WS_WBR) + 2 * 1024 * 512, 32, 4, nullptr, scr, it - I5, lane);
            else if (it < I7) transpose_item(a.in[22], 1024, 1024, (bf16_t*)(ws + WS_WOUT), 32, 4, nullptr, scr, it - I6, lane);
            else if (it < I8) transpose_item(a.in[24], 1024, UPN, (bf16_t*)(ws + WS_WUP), 176, 8, a.in[23], scr, it - I7, lane);
            else transpose_item(a.in[27], DFF, 1024, (bf16_t*)(ws + WS_WDN), 32, 4, nullptr, scr, it - I8, lane);
        }
        f32x4 gv[4];
#pragma unroll
        for (int j = 0; j < 4; ++j) gv[j] = ((const f32x4*)a.in[2])[lane + 64 * j];
        const float fbias = a.in[14][lane & 7];
        {
        f32x4 nx[4];
        if (gw < NTOK) { const f32x4* xr = (const f32x4*)(x + (size_t)gw * DM) + lane;
#pragma unroll
            for (int j = 0; j < 4; ++j) nx[j] = xr[64 * j]; }
        for (int m = gw; m < NTOK; m += NGW) {
            f32x4 v[4]; float s = 0.f;
#pragma unroll
            for (int j = 0; j < 4; ++j) v[j] = nx[j];
            if (m + NGW < NTOK) { const f32x4* xr = (const f32x4*)(x + (size_t)(m + NGW) * DM) + lane;
#pragma unroll
                for (int j = 0; j < 4; ++j) nx[j] = xr[64 * j]; }
#pragma unroll
            for (int j = 0; j < 4; ++j) s += (v[j][0] * v[j][0] + v[j][1] * v[j][1]) + (v[j][2] * v[j][2] + v[j][3] * v[j][3]);
            const float rstd = rsqrtf(wave_sum(s) * (1.f / DM) + EPS);
            unsigned long long* o8 = (unsigned long long*)(H + (size_t)m * DM) + lane;
            float fg[8];
#pragma unroll
            for (int g = 0; g < 8; ++g) fg[g] = 0.f;
#pragma unroll
            for (int j = 0; j < 4; ++j) {
                v[j] = v[j] * rstd * gv[j];
                o8[64 * j] = (unsigned long long)cvtpk(v[j][0], v[j][1]) | ((unsigned long long)cvtpk(v[j][2], v[j][3]) << 32);
#pragma unroll
                for (int e = 0; e < 4; ++e) { const LAS f32x4* wp = (const LAS f32x4*)(wl + ((j * 4 + e) * 64 + lane) * 8); const f32x4 w0 = wp[0], w1 = wp[1];
                    fg[0] += v[j][e] * w0[0]; fg[1] += v[j][e] * w0[1]; fg[2] += v[j][e] * w0[2]; fg[3] += v[j][e] * w0[3];
                    fg[4] += v[j][e] * w1[0]; fg[5] += v[j][e] * w1[1]; fg[6] += v[j][e] * w1[2]; fg[7] += v[j][e] * w1[3]; }
            }
            float mine = 0.f;
#pragma unroll
            for (int g = 0; g < 8; ++g) { const float t = wave_sum(fg[g]); if ((lane & 7) == g) mine = t; }
            if (lane < 8) { const float z = mine + fbias; const float lf = fminf(z, 0.f) - log1pf(__expf(-fabsf(z)));
                LOGF[(size_t)((m >> 11) * 8 + lane) * SEQ + (m & 2047)] = lf; }
        }
        }
#pragma unroll
        for (int j = 0; j < 4; ++j) gv[j] = ((const f32x4*)a.in[15])[lane + 64 * j];
        for (int m = gw; m < NMTOK; m += NGW) {
            const f32x4* xr = (const f32x4*)(a.in[1] + (size_t)m * DM) + lane;
            f32x4 v[4]; float s = 0.f;
#pragma unroll
            for (int j = 0; j < 4; ++j) { v[j] = xr[64 * j]; s += (v[j][0] * v[j][0] + v[j][1] * v[j][1]) + (v[j][2] * v[j][2] + v[j][3] * v[j][3]); }
            const float rstd = rsqrtf(wave_sum(s) * (1.f / DM) + EPS);
            unsigned long long* o8 = (unsigned long long*)(MH + (size_t)m * DM) + lane;
#pragma unroll
            for (int j = 0; j < 4; ++j) { v[j] = v[j] * rstd * gv[j]; o8[64 * j] = (unsigned long long)cvtpk(v[j][0], v[j][1]) | ((unsigned long long)cvtpk(v[j][2], v[j][3]) << 32); }
        }
        __syncthreads();
    }
    SYNC_AFTER(0);

    if (IN(1)) {
        if (bx >= G - 16) {
            const int seq = (bx - (G - 16)) * 8 + wid;
            if (seq < NB * 8) {
                const f32x4* src = (const f32x4*)(LOGF + (size_t)seq * SEQ + lane * 32);
                float run = 0.f;
#pragma unroll
                for (int i = 0; i < 8; ++i) { const f32x4 v = src[i]; run += (v[0] + v[1]) + (v[2] + v[3]); }
                float incl = run;
#pragma unroll
                for (int o = 1; o < 64; o <<= 1) { const float t = __shfl_up(incl, o); if (lane >= o) incl += t; }
                float pre = incl - run;
                f32x4* dst = (f32x4*)(C2 + (size_t)seq * SEQ + lane * 32);
#pragma unroll
                for (int i = 0; i < 8; ++i) { f32x4 v = src[i]; v[0] += pre; v[1] += v[0]; v[2] += v[1]; v[3] += v[2]; pre = v[3]; dst[i] = v * LOG2E; }
            }
        }
        { pg8::Gemm g{(const char*)H, (const char*)(ws + WS_W1), 1024, 0, 0, 0}; pg8::Order S; S.init(NTOK, UPN, G, bx, 1);
          EpiProj E{(bf16_t*)(ws + WS_QK), (unsigned char*)(ws + WS_G), (const float*)(ws + WS_CTL + 4096), a.in[4]};
          pg8::gemm_phase<EpiProj>(lds, g, S, E); }
        { pg8::Gemm g{(const char*)(ws + WS_WV), (const char*)H, 1024, 0, 0, 0}; pg8::Order S; S.init(1024, NTOK, G, bx, 1);
          EpiNat E{VT, NTOK};
          pg8::gemm_phase<EpiNat>(lds, g, S, E); }
    }
    SYNC_AFTER(1);

    if (IN(2)) {
        AttnP P{(const bf16_t*)(ws + WS_QK), VT, (const bf16_t*)(ws + WS_MK), (const bf16_t*)(ws + WS_MVT), C2, (bf16_t*)(ws + WS_O), a.out,
                a.in[7], a.in[8], a.in[9], a.in[10], a.in[11], a.in[17], a.in[18], (const float*)(ws + WS_CTL + 4096)};
        LAS int* uw = (LAS int*)(lds + AT_UNITW);
        for (int j = bx; j < 64; j += G) {
            if (j < 32) { pg8::Gemm g{(const char*)MH, (const char*)(ws + WS_WMK), 1024, 0, 0, 0}; pg8::Order S; S.init(NMTOK, 512, 32, j, 1);
                EpiPlain E{(bf16_t*)(ws + WS_MK), 512};
                pg8::gemm_phase<EpiPlain>(lds, g, S, E); }
            else { pg8::Gemm g{(const char*)(ws + WS_WMV), (const char*)MH, 1024, 0, 0, 0}; pg8::Order S; S.init(512, NMTOK, 32, j - 32, 1);
                EpiNat E{(bf16_t*)(ws + WS_MVT), NMTOK};
                pg8::gemm_phase<EpiNat>(lds, g, S, E); }
            asm volatile("s_waitcnt vmcnt(0)" ::: "memory");
            __syncthreads();
            if (tid == 0) { __builtin_amdgcn_fence(__ATOMIC_RELEASE, "agent"); asm volatile("s_waitcnt vmcnt(0)" ::: "memory");
                __hip_atomic_fetch_add(CTL + 128, 1u, __ATOMIC_RELAXED, __HIP_MEMORY_SCOPE_AGENT); }
        }
        bool mem_ready = false;
        int idx = bx;
        if (wid >= 4) __builtin_amdgcn_s_setprio(1);
        for (;;) {
            if (idx >= N_ATT_UNITS) break;
            unsigned nxt = 0u;
            if (tid == 0) nxt = atomicAdd(CTL, 1u);
            int kind, qb, sub; decode_unit(idx, kind, qb, sub);
            if (kind == 0) attn_unit<0>(lds, P, sub >> 2, sub & 3, qb);
            else if (kind == 1) attn_fx64(lds, P, sub >> 3, sub & 7, qb);
            else {
                if (!mem_ready) {
                    if (tid == 0) { while (__hip_atomic_load(CTL + 128, __ATOMIC_RELAXED, __HIP_MEMORY_SCOPE_AGENT) < 64u) __builtin_amdgcn_s_sleep(8);
                        __builtin_amdgcn_fence(__ATOMIC_ACQUIRE, "agent"); asm volatile("s_waitcnt vmcnt(0)" ::: "memory"); }
                    __syncthreads();
                    mem_ready = true;
                }
                attn_unit<2>(lds, P, sub >> 2, sub & 3, qb);
            }
            if (tid == 0) *uw = G + (int)nxt;
            __syncthreads();
            idx = __builtin_amdgcn_readfirstlane(*uw);
            __syncthreads();
        }
        __builtin_amdgcn_s_setprio(0);
    }
    SYNC_AFTER(2);

    if (IN(3)) {
        pg8::Gemm g{(const char*)(ws + WS_O), (const char*)(ws + WS_WBR), 512, 0, (size_t)NTOK * 512 * 2, (size_t)1024 * 512 * 2}; pg8::Order S; S.init(NTOK, DM, G, bx, 3);
        EpiMerge E{(const unsigned char*)(ws + WS_G), (bf16_t*)(ws + WS_MERGED)};
        pg8::gemm_phase<EpiMerge>(lds, g, S, E);
    }
    SYNC_AFTER(3);

    if (IN(4)) {
        pg8::Gemm g{(const char*)(ws + WS_MERGED), (const char*)(ws + WS_WOUT), 1024, 0, 0, 0}; pg8::Order S; S.init(NTOK, DM, G, bx, 1);
        EpiOut E{x, a.out, (bf16_t*)(ws + WS_X1B), SS};
        pg8::gemm_phase<EpiOut>(lds, g, S, E);
    }
    SYNC_AFTER(4);

    if (IN(5)) {
        pg8::Gemm g{(const char*)(ws + WS_X1B), (const char*)(ws + WS_WUP), 1024, 1, 0, 0}; pg8::Order S; S.init(NTOK, UPN, G, bx, 1);
        EpiUp E{SS, a.in[25], a.in[26], (bf16_t*)(ws + WS_ACT), (float*)(ws + WS_UB)};
        pg8::gemm_phase<EpiUp>(lds, g, S, E);
    }
    SYNC_AFTER(5);

    if (IN(6)) {
        pg8::Order S; S.init(NTOK, DM, G, bx, 1);
        const float* UB = (const float*)(ws + WS_UB); bf16_t* ACT = (bf16_t*)(ws + WS_ACT);
        const float* cw = a.in[25]; const float* cb = a.in[26];
        Unit u;
        for (int i = 0; S.next(i, u); ++i) {
            for (int gg = 0; gg < 2; ++gg) {
                const int grp = u.pm * 2 + gg; const bool hasprev = (grp & 15) != 0;
                const float* ub = UB + (size_t)grp * DFF * 8; const float* pb = UB + (size_t)(grp - 1) * DFF * 8 + 4;
                for (int ch = tid; ch < DFF; ch += 512) {
                    const f32x4 uf = *(const f32x4*)(ub + (size_t)ch * 8);
                    const float u0a = uf[0], u0g = uf[1], u1a = uf[2], u1g = uf[3];
                    float p2a = 0.f, p1a = 0.f, p2g = 0.f, p1g = 0.f;
                    if (hasprev) { const f32x4 pf_ = *(const f32x4*)(pb + (size_t)ch * 8); p2a = pf_[0]; p2g = pf_[1]; p1a = pf_[2]; p1g = pf_[3]; }
                    const float wa0 = cw[ch], wa1 = cw[UPN + ch], wa2 = cw[2 * UPN + ch], ba = cb[ch];
                    const float wg0 = cw[DFF + ch], wg1 = cw[UPN + DFF + ch], wg2 = cw[2 * UPN + DFF + ch], bg = cb[DFF + ch];
                    const float ca0 = wa0 * p2a + wa1 * p1a + wa2 * u0a + ba, cg0 = wg0 * p2g + wg1 * p1g + wg2 * u0g + bg;
                    const float ca1 = wa0 * p1a + wa1 * u0a + wa2 * u1a + ba, cg1 = wg0 * p1g + wg1 * u0g + wg2 * u1g + bg;
                    const unsigned w0 = cvtpk(ca0 * sigmoidf_(ca0) * cg0, 0.f), w1 = cvtpk(ca1 * sigmoidf_(ca1) * cg1, 0.f);
                    ACT[(size_t)(grp * 128) * DFF + ch] = (bf16_t)(w0 & 0xffffu);
                    ACT[(size_t)(grp * 128 + 1) * DFF + ch] = (bf16_t)(w1 & 0xffffu);
                }
            }
        }
        asm volatile("s_waitcnt vmcnt(0)" ::: "memory");
        __syncthreads();
        pg8::Gemm g{(const char*)(ws + WS_ACT), (const char*)(ws + WS_WDN), DFF, 0, 0, 0};
        EpiDown E{a.out, (const bf16_t*)(ws + WS_X1B)};
        pg8::gemm_phase<EpiDown>(lds, g, S, E);
    }
#undef IN
#undef SYNC_AFTER
}

extern "C" void kernel_launch(void* const* d_in, const int* in_sizes, int n_in, void* d_out, int out_size, void* d_ws, size_t ws_size, hipStream_t stream) {
    static int grid = 0;
    if (grid == 0) {
        int dev = 0, cus = 0, per_cu = 0;
        if (hipGetDevice(&dev) != hipSuccess || hipDeviceGetAttribute(&cus, hipDeviceAttributeMultiprocessorCount, dev) != hipSuccess) { fprintf(stderr, "kernel_launch: device query failed\n"); grid = -1; return; }
        if (hipFuncSetAttribute((const void*)mega_fwd, hipFuncAttributeMaxDynamicSharedMemorySize, LDS_BYTES) != hipSuccess) { fprintf(stderr, "kernel_launch: hipFuncSetAttribute failed\n"); grid = -1; return; }
        if (hipOccupancyMaxActiveBlocksPerMultiprocessor(&per_cu, (const void*)mega_fwd, 512, LDS_BYTES) != hipSuccess || per_cu < 1) { fprintf(stderr, "kernel_launch: occupancy query says %d\n", per_cu); per_cu = 1; }
        (void)hipGetLastError();
        grid = cus * per_cu;
        if (n_in != 28 || ws_size < 512 * MiB) fprintf(stderr, "kernel_launch: unexpected n_in %d / ws %zu\n", n_in, ws_size);
    }
    if (grid < 0) return;
    Args a{};
    for (int i = 0; i < 28; ++i) a.in[i] = (const float*)d_in[i];
    a.out = (float*)d_out; a.ws = (unsigned char*)d_ws;
#if MK_PER_PHASE
    for (int p = 0; p < 7; ++p) { a.ph_lo = p; a.ph_hi = p + 1; hipLaunchKernelGGL(mega_fwd, dim3(grid), dim3(512), LDS_BYTES, stream, a); }
#else
    (void)hipMemsetAsync(d_ws, 0, 24576, stream);
    a.ph_lo = 0; a.ph_hi = 7;
    void* args[] = {&a};
    hipError_t e = hipLaunchCooperativeKernel((const void*)mega_fwd, dim3(grid), dim3(512), args, LDS_BYTES, stream);
    if (e != hipSuccess) fprintf(stderr, "kernel_launch: cooperative launch failed: %s (grid %d)\n", hipGetErrorString(e), grid);
#endif
}
```

```cpp
#include <hip/hip_runtime.h>
#include <hip/hip_cooperative_groups.h>
#include <cstdio>
#include <cstdint>
namespace cg = cooperative_groups;

#ifndef MK_PER_PHASE
#define MK_PER_PHASE 0
#endif

#define LAS __attribute__((address_space(3)))
typedef unsigned short bf16_t;
typedef short bf16x8 __attribute__((ext_vector_type(8)));
typedef short s16x4 __attribute__((ext_vector_type(4)));
typedef float f32x4 __attribute__((ext_vector_type(4)));
typedef float f32x16 __attribute__((ext_vector_type(16)));
typedef float f32x2 __attribute__((ext_vector_type(2)));
typedef unsigned u32x4 __attribute__((ext_vector_type(4)));
typedef unsigned u32x2 __attribute__((ext_vector_type(2)));
typedef __bf16 bf16x2_t __attribute__((ext_vector_type(2)));

constexpr int DM = 1024, NB = 16, SEQ = 2048, NTOK = NB * SEQ, NMEM = 256, NMTOK = NB * NMEM;
constexpr int INCOLS = 6664, DFF = 2816, UPN = 5632;
constexpr float EPS = 1e-6f, LOG2E = 1.4426950408889634f;
constexpr int QKP = 2560, GP = 3072;
constexpr int NWAVES = 8;
constexpr int LDS_BYTES = 147456;

constexpr size_t MiB = 1u << 20;
constexpr size_t WS_CTL = 0, WS_LOGF = 1 * MiB, WS_C2 = 2 * MiB, WS_SS = 3 * MiB, WS_MK = 4 * MiB, WS_MVT = 8 * MiB;
constexpr size_t WS_W1 = 12 * MiB, WS_WV = 23 * MiB, WS_WMK = 25 * MiB, WS_WMV = 26 * MiB, WS_WBR = 27 * MiB, WS_WOUT = 30 * MiB;
constexpr size_t WS_WUP = 32 * MiB, WS_WDN = 43 * MiB, WS_MH = 56 * MiB;
constexpr size_t WS_QK = 64 * MiB, WS_G = 224 * MiB, WS_O = 416 * MiB;
constexpr size_t WS_MERGED = 64 * MiB, WS_X1B = 128 * MiB, WS_ACT = 224 * MiB, WS_UB = 400 * MiB;

__device__ __forceinline__ unsigned cvtpk(float lo, float hi) { f32x2 v = {lo, hi}; bf16x2_t b = __builtin_convertvector(v, bf16x2_t); return __builtin_bit_cast(unsigned, b); }
__device__ __forceinline__ float bf2f(unsigned short b) { return __uint_as_float((unsigned)b << 16); }
__device__ __forceinline__ float bflo(unsigned w) { return __uint_as_float(w << 16); }
__device__ __forceinline__ float bfhi(unsigned w) { return __uint_as_float(w & 0xffff0000u); }
__device__ __forceinline__ float dpp_shr1(float v) { return __int_as_float(__builtin_amdgcn_update_dpp(0, __float_as_int(v), 0x111  , 0xf, 0xf, false)); }
__device__ __forceinline__ float wave_sum(float v) {
    v += __int_as_float(__builtin_amdgcn_update_dpp(0, __float_as_int(v), 0xB1, 0xf, 0xf, false));
    v += __int_as_float(__builtin_amdgcn_update_dpp(0, __float_as_int(v), 0x4E, 0xf, 0xf, false));
    v += __int_as_float(__builtin_amdgcn_update_dpp(0, __float_as_int(v), 0x141, 0xf, 0xf, false));
    v += __int_as_float(__builtin_amdgcn_update_dpp(0, __float_as_int(v), 0x140, 0xf, 0xf, false));
    v += __int_as_float(__builtin_amdgcn_update_dpp(0, __float_as_int(v), 0x142, 0xa, 0xf, false));
    v += __int_as_float(__builtin_amdgcn_update_dpp(0, __float_as_int(v), 0x143, 0xc, 0xf, false));
    return __int_as_float(__builtin_amdgcn_readlane(__float_as_int(v), 63));
}
__device__ __forceinline__ float sum_fq(float v) {
    { const auto r = __builtin_amdgcn_permlane16_swap(__float_as_uint(v), __float_as_uint(v), false, false); v = __uint_as_float(r[0]) + __uint_as_float(r[1]); }
    { const auto r = __builtin_amdgcn_permlane32_swap(__float_as_uint(v), __float_as_uint(v), false, false); v = __uint_as_float(r[0]) + __uint_as_float(r[1]); }
    return v;
}
__device__ __forceinline__ float row16_sum(float v) {
    v += __int_as_float(__builtin_amdgcn_update_dpp(0, __float_as_int(v), 0xB1, 0xf, 0xf, false));
    v += __int_as_float(__builtin_amdgcn_update_dpp(0, __float_as_int(v), 0x4E, 0xf, 0xf, false));
    v += __int_as_float(__builtin_amdgcn_update_dpp(0, __float_as_int(v), 0x141, 0xf, 0xf, false));
    v += __int_as_float(__builtin_amdgcn_update_dpp(0, __float_as_int(v), 0x140, 0xf, 0xf, false));
    return v;
}
__device__ __forceinline__ float fast_exp2(float x) { return __builtin_amdgcn_exp2f(x); }
__device__ __forceinline__ float fast_rcp(float x) { return __builtin_amdgcn_rcpf(x); }
__device__ __forceinline__ float sigmoidf_(float z) { return fast_rcp(1.f + fast_exp2(-z * LOG2E)); }

namespace pg8 {
constexpr int BM = 256, BK = 64, HALF = 128, HTB = HALF * BK * 2, STAGE_BYTES = 8 * HTB, NXCD = 8, WGM = 8;
__host__ __device__ __forceinline__ int lds_byte(int r, int c) { const int st = (r >> 4) * 2 + (c >> 5), rr = r & 15, cc = c & 31, ob = rr * 64 + cc * 2; return st * 1024 + (ob ^ (((ob >> 9) & 1) << 5)); }
__host__ __device__ __forceinline__ void stage_rc(int b, int& R, int& C) { const int st = b / 1024, sb = b % 1024, swz = sb ^ (((sb >> 9) & 1) << 5); R = (st >> 1) * 16 + swz / 64; C = (st & 1) * 32 + (swz % 64) / 2; }

struct Unit { int pm, pn, seg; };
struct Gemm { const char* A; const char* Bt; int K; int a_perm; size_t a_seg, b_seg; };

struct Order {
    int nM, nN, nwg, G, c, nseg;
    __device__ void init(int M, int N, int G_, int c_, int nseg_) { nM = M / BM; nN = N / BM; nwg = nM * nN; G = G_; c = c_; nseg = nseg_; }
    __device__ bool next(int i, Unit& u) const {
        const int seg = i % nseg, ii = i / nseg;
        const long L = (long)ii * G + c; if (L >= nwg) return false;
        int wgid = (int)L; { const int q = nwg / NXCD, r = nwg % NXCD, xcd = wgid % NXCD, off = wgid / NXCD; wgid = (xcd < r ? xcd * (q + 1) : r * (q + 1) + (xcd - r) * q) + off; }
        const int nig = WGM * nN, gid = wgid / nig, fm = gid * WGM, gsz = (nM - fm) < WGM ? (nM - fm) : WGM;
        u.pm = fm + ((wgid % nig) % gsz); u.pn = (wgid % nig) / gsz; u.seg = seg; return true;
    }
};

template <class Epi>
__device__ __forceinline__ void gemm_phase(LAS unsigned char* lds, const Gemm g, const Order& S, const Epi& E) {
    const int tid = threadIdx.x, wid = __builtin_amdgcn_readfirstlane(tid >> 6), lane = tid & 63, wr = wid >> 2, wc = wid & 3, fr = lane & 15, fq = lane >> 4;
    const int K = g.K, nt = K / BK;
    unsigned voffA[2], voffB[2];
#pragma unroll
    for (int i = 0; i < 2; ++i) { int R, C; stage_rc(tid * 16 + i * 8192, R, C);
        const int Ra = g.a_perm ? (8 * (16 * (R >> 6) + (R & 15)) + ((R >> 4) & 3)) : R;
        voffA[i] = (unsigned)(Ra * K + C) * 2u; voffB[i] = (unsigned)(R * K + C) * 2u; }
    const size_t kstep = (size_t)(BK * 2);
    const size_t hstep = (size_t)HALF * K * 2;
    const size_t hstepA = g.a_perm ? (size_t)4 * K * 2 : hstep;
    const size_t tstep = 2 * hstep;
    const unsigned ldsw = (unsigned)wid * 1024u;
    const int aoff = lds_byte(wr * 64 + fr, fq * 8), boff = lds_byte(wc * 32 + fr, fq * 8);
#define PG8_SA(b, h) (((b) * 2 + (h)) * HTB)
#define PG8_SB(b, h) ((4 + (b) * 2 + (h)) * HTB)
#define PG8_STAGE(bufoff, gbase, voff) do { _Pragma("unroll") for (int _i = 0; _i < 2; ++_i) \
        __builtin_amdgcn_global_load_lds((const unsigned*)((const char*)(gbase) + (voff)[_i]), (LAS unsigned*)(lds + (bufoff) + ldsw + _i * 8192), 16, 0, 0); } while (0)
#define PG8_LDA(dst, b, h) do { _Pragma("unroll") for (int m = 0; m < 4; ++m) _Pragma("unroll") for (int k = 0; k < 2; ++k) dst[m][k] = *(const LAS bf16x8*)(lds + PG8_SA(b, h) + aoff + m * 2048 + k * 1024); } while (0)
#define PG8_LDB(dst, b, h) do { _Pragma("unroll") for (int n = 0; n < 2; ++n) _Pragma("unroll") for (int k = 0; k < 2; ++k) dst[n][k] = *(const LAS bf16x8*)(lds + PG8_SB(b, h) + boff + n * 2048 + k * 1024); } while (0)
#define PG8_MMA(ai, bj, At, Bt) do { __builtin_amdgcn_s_setprio(1); _Pragma("unroll") for (int m = 0; m < 4; ++m) _Pragma("unroll") for (int n = 0; n < 2; ++n) _Pragma("unroll") for (int k = 0; k < 2; ++k) \
        acc[ai][bj][m][n] = __builtin_amdgcn_mfma_f32_16x16x32_bf16(Bt[n][k], At[m][k], acc[ai][bj][m][n], 0, 0, 0); __builtin_amdgcn_s_setprio(0); } while (0)
#define PG8_WAIT_V(n) asm volatile("s_waitcnt vmcnt(" #n ")" ::: "memory")
#define PG8_WAIT_L(n) asm volatile("s_waitcnt lgkmcnt(" #n ")" ::: "memory")
#define PG8_BAR __builtin_amdgcn_s_barrier()
#define PG8_SCHED __builtin_amdgcn_sched_barrier(0)
    Unit cur, nxt; int ui = 0;
    if (!S.next(0, cur)) return;
    f32x4 acc[2][2][4][2];
#pragma unroll
    for (int a = 0; a < 2; ++a)
#pragma unroll
        for (int b = 0; b < 2; ++b)
#pragma unroll
            for (int m = 0; m < 4; ++m)
#pragma unroll
                for (int n = 0; n < 2; ++n) acc[a][b][m][n] = (f32x4){0.f, 0.f, 0.f, 0.f};
    bf16x8 At[4][2], B0[2][2], B1[2][2];
    const char* cA = g.A + (size_t)cur.pm * tstep + (size_t)cur.seg * g.a_seg; const char* cB = g.Bt + (size_t)cur.pn * tstep + (size_t)cur.seg * g.b_seg;
    PG8_STAGE(PG8_SB(0, 0), cB, voffB); PG8_STAGE(PG8_SB(0, 1), cB + hstep, voffB); PG8_STAGE(PG8_SA(0, 0), cA, voffA); PG8_STAGE(PG8_SA(0, 1), cA + hstepA, voffA);
    if (wr == 1) PG8_BAR;
    PG8_WAIT_V(2); PG8_BAR;
    PG8_STAGE(PG8_SB(1, 0), cB + kstep, voffB); PG8_STAGE(PG8_SA(1, 0), cA + kstep, voffA); PG8_STAGE(PG8_SB(1, 1), cB + hstep + kstep, voffB);
    PG8_WAIT_V(6); PG8_BAR;
    for (;;) {
        const bool has_next = S.next(ui + 1, nxt);
        const char* nA = has_next ? g.A + (size_t)nxt.pm * tstep + (size_t)nxt.seg * g.a_seg : cA; const char* nB = has_next ? g.Bt + (size_t)nxt.pn * tstep + (size_t)nxt.seg * g.b_seg : cB;
        for (int t = 0; t < nt; t += 2) {
            const bool last = (t == nt - 2);
            const char* a1 = cA + (size_t)(t + 1) * kstep;
            const char* a2 = last ? nA : cA + (size_t)(t + 2) * kstep; const char* b2 = last ? nB : cB + (size_t)(t + 2) * kstep;
            const char* a3 = a2 + kstep; const char* b3 = b2 + kstep;
            PG8_LDB(B0, 0, 0); PG8_LDB(B1, 0, 1); PG8_SCHED; PG8_LDA(At, 0, 0); PG8_STAGE(PG8_SA(1, 1), a1 + hstepA, voffA);
            PG8_WAIT_V(8); PG8_WAIT_L(0); PG8_BAR; PG8_MMA(0, 0, At, B0); PG8_MMA(0, 1, At, B1); PG8_BAR; PG8_SCHED;
            PG8_LDA(At, 0, 1); PG8_STAGE(PG8_SB(0, 0), b2, voffB); PG8_STAGE(PG8_SB(0, 1), b2 + hstep, voffB); PG8_STAGE(PG8_SA(0, 0), a2, voffA);
            PG8_WAIT_V(8); PG8_WAIT_L(0); PG8_BAR; PG8_MMA(1, 0, At, B0); PG8_MMA(1, 1, At, B1); PG8_BAR; PG8_SCHED;
            PG8_LDB(B0, 1, 0); PG8_LDB(B1, 1, 1); PG8_SCHED; PG8_LDA(At, 1, 0); PG8_STAGE(PG8_SA(0, 1), a2 + hstepA, voffA);
            PG8_WAIT_V(8); PG8_WAIT_L(0); PG8_BAR; PG8_MMA(0, 0, At, B0); PG8_MMA(0, 1, At, B1); PG8_BAR; PG8_SCHED;
            PG8_LDA(At, 1, 1); PG8_STAGE(PG8_SB(1, 0), b3, voffB); PG8_STAGE(PG8_SB(1, 1), b3 + hstep, voffB); PG8_STAGE(PG8_SA(1, 0), a3, voffA);
            PG8_WAIT_V(8); PG8_WAIT_L(0); PG8_BAR; PG8_MMA(1, 0, At, B0); PG8_MMA(1, 1, At, B1); PG8_BAR; PG8_SCHED;
        }
        if (wr == 0) PG8_BAR;
        E(acc, cur, wr, wc, fr, fq);
        if (!has_next) break;
        if (E.reset_after(cur))
#pragma unroll
        for (int a = 0; a < 2; ++a)
#pragma unroll
            for (int b = 0; b < 2; ++b)
#pragma unroll
                for (int m = 0; m < 4; ++m)
#pragma unroll
                    for (int n = 0; n < 2; ++n) acc[a][b][m][n] = (f32x4){0.f, 0.f, 0.f, 0.f};
        cur = nxt; cA = nA; cB = nB; ++ui;
        if (wr == 1) PG8_BAR;
    }
    PG8_WAIT_V(0);
    PG8_BAR;
#undef PG8_SA
#undef PG8_SB
#undef PG8_STAGE
#undef PG8_LDA
#undef PG8_LDB
#undef PG8_MMA
#undef PG8_WAIT_V
#undef PG8_WAIT_L
#undef PG8_BAR
#undef PG8_SCHED
}
}
using pg8::Unit;
typedef f32x4 Acc[2][2][4][2];

__device__ __forceinline__ int perm16(int c) { return ((c >> 5) & 3) * 64 + ((c >> 2) & 3) * 16 + (c >> 7) * 8 + ((c >> 4) & 1) * 4 + (c & 3); }

struct EpiProj {
    __device__ __forceinline__ bool reset_after(const Unit&) const { return true; }
    bf16_t* QK; unsigned char* G; const float* GN; const float* b_gate;
    __device__ __forceinline__ void operator()(const Acc& acc, const Unit& u, int wr, int wc, int fr, int fq) const {
        const int row0 = u.pm * 256 + wr * 64 + fr, lcol = wc * 64 + fq * 16;
        if (u.pn < 10) {
            const int kind = u.pn >> 1;
            bf16_t* base = QK + (size_t)row0 * QKP + u.pn * 256 + lcol;
            if (kind < 4) {
                const float* gp = GN + kind * 64 + fq * 16;
                const f32x4 gn0 = *(const f32x4*)(gp), gn1 = *(const f32x4*)(gp + 4), gn2 = *(const f32x4*)(gp + 8), gn3 = *(const f32x4*)(gp + 12);
#pragma unroll
                for (int ai = 0; ai < 2; ++ai)
#pragma unroll
                    for (int m = 0; m < 4; ++m) {
                        float ss = 0.f;
#pragma unroll
                        for (int bj = 0; bj < 2; ++bj)
#pragma unroll
                            for (int n = 0; n < 2; ++n) { const f32x4 v = acc[ai][bj][m][n]; ss += (v[0] * v[0] + v[1] * v[1]) + (v[2] * v[2] + v[3] * v[3]); }
                        ss = sum_fq(ss);
                        const float rs = rsqrtf(ss * (1.f / 64.f) + EPS);
                        bf16_t* rowp = base + (size_t)(ai * 128 + m * 16) * QKP;
#pragma unroll
                        for (int bj = 0; bj < 2; ++bj) {
                            const f32x4 v0 = acc[ai][bj][m][0] * rs * (bj ? gn2 : gn0), v1 = acc[ai][bj][m][1] * rs * (bj ? gn3 : gn1);
                            u32x4 w; w.x = cvtpk(v0[0], v0[1]); w.y = cvtpk(v0[2], v0[3]); w.z = cvtpk(v1[0], v1[1]); w.w = cvtpk(v1[2], v1[3]);
                            *(u32x4*)(rowp + 8 * bj) = w; }
                    }
            } else {
#pragma unroll
                for (int ai = 0; ai < 2; ++ai)
#pragma unroll
                    for (int m = 0; m < 4; ++m) {
                        bf16_t* rowp = base + (size_t)(ai * 128 + m * 16) * QKP;
#pragma unroll
                        for (int bj = 0; bj < 2; ++bj) {
                            const f32x4 v0 = acc[ai][bj][m][0], v1 = acc[ai][bj][m][1];
                            u32x4 w; w.x = cvtpk(v0[0], v0[1]); w.y = cvtpk(v0[2], v0[3]); w.z = cvtpk(v1[0], v1[1]); w.w = cvtpk(v1[2], v1[3]);
                            *(u32x4*)(rowp + 8 * bj) = w; }
                    }
            }
        } else {
            const int col = (u.pn - 10) * 256 + lcol;
            unsigned char* base = G + (size_t)row0 * GP + col;
            const f32x4 bv0 = *(const f32x4*)(b_gate + col), bv1 = *(const f32x4*)(b_gate + col + 4), bv2 = *(const f32x4*)(b_gate + col + 8), bv3 = *(const f32x4*)(b_gate + col + 12);
#pragma unroll
            for (int ai = 0; ai < 2; ++ai)
#pragma unroll
                for (int m = 0; m < 4; ++m) {
                    u32x4 w;
#pragma unroll
                    for (int bj = 0; bj < 2; ++bj)
#pragma unroll
                        for (int n = 0; n < 2; ++n) {
                            const f32x4 v = acc[ai][bj][m][n] + (bj ? (n ? bv3 : bv2) : (n ? bv1 : bv0));
                            const unsigned q0 = (unsigned)fmaxf(sigmoidf_(v[0]) * 255.f + 0.5f, 1.f), q1 = (unsigned)fmaxf(sigmoidf_(v[1]) * 255.f + 0.5f, 1.f), q2 = (unsigned)fmaxf(sigmoidf_(v[2]) * 255.f + 0.5f, 1.f), q3 = (unsigned)fmaxf(sigmoidf_(v[3]) * 255.f + 0.5f, 1.f);
                            w[2 * bj + n] = q0 | (q1 << 8) | (q2 << 16) | (q3 << 24);
                        }
                    *(u32x4*)(base + (size_t)(ai * 128 + m * 16) * GP) = w;
                }
        }
    }
};
struct EpiNat {
    __device__ __forceinline__ bool reset_after(const Unit&) const { return true; }
    bf16_t* O; int ldc;
    __device__ __forceinline__ void operator()(const Acc& acc, const Unit& u, int wr, int wc, int fr, int fq) const {
        bf16_t* base = O + (size_t)(u.pm * 256 + wr * 64 + fr) * ldc + u.pn * 256 + wc * 32 + fq * 4;
#pragma unroll
        for (int ai = 0; ai < 2; ++ai)
#pragma unroll
            for (int m = 0; m < 4; ++m) {
                bf16_t* rowp = base + (size_t)(ai * 128 + m * 16) * ldc;
#pragma unroll
                for (int bj = 0; bj < 2; ++bj)
#pragma unroll
                    for (int n = 0; n < 2; ++n) { const f32x4 v = acc[ai][bj][m][n]; u32x2 w; w.x = cvtpk(v[0], v[1]); w.y = cvtpk(v[2], v[3]); *(u32x2*)(rowp + bj * 128 + n * 16) = w; }
            }
    }
};
struct EpiPlain {
    __device__ __forceinline__ bool reset_after(const Unit&) const { return true; }
    bf16_t* O; int ldc;
    __device__ __forceinline__ void operator()(const Acc& acc, const Unit& u, int wr, int wc, int fr, int fq) const {
        bf16_t* base = O + (size_t)(u.pm * 256 + wr * 64 + fr) * ldc + u.pn * 256 + wc * 64 + fq * 16;
#pragma unroll
        for (int ai = 0; ai < 2; ++ai)
#pragma unroll
            for (int m = 0; m < 4; ++m) {
                bf16_t* rowp = base + (size_t)(ai * 128 + m * 16) * ldc;
#pragma unroll
                for (int bj = 0; bj < 2; ++bj) {
                    const f32x4 v0 = acc[ai][bj][m][0], v1 = acc[ai][bj][m][1];
                    u32x4 w; w.x = cvtpk(v0[0], v0[1]); w.y = cvtpk(v0[2], v0[3]); w.z = cvtpk(v1[0], v1[1]); w.w = cvtpk(v1[2], v1[3]);
                    *(u32x4*)(rowp + 8 * bj) = w; }
            }
    }
};
__device__ __forceinline__ f32x4 gate4(unsigned w) { f32x4 g; g[0] = (float)(w & 0xffu); g[1] = (float)((w >> 8) & 0xffu); g[2] = (float)((w >> 16) & 0xffu); g[3] = (float)(w >> 24);
    return g; }
struct EpiMerge {
    __device__ __forceinline__ bool reset_after(const Unit& u) const { return u.seg == 2; }
    const unsigned char* G; bf16_t* MERGED;
    __device__ __forceinline__ void operator()(Acc& acc, const Unit& u, int wr, int wc, int fr, int fq) const {
        const int row0 = u.pm * 256 + wr * 64 + fr, col = u.pn * 256 + wc * 64 + fq * 16;
        const unsigned char* gbase = G + (size_t)row0 * GP + u.seg * 1024 + col;
        u32x4 gn[8], gd[8];
#pragma unroll
        for (int i = 0; i < 8; ++i) gn[i] = *(const u32x4*)(gbase + (size_t)((i >> 2) * 128 + (i & 3) * 16) * GP);
        if (u.seg < 2) {
#pragma unroll
            for (int i = 0; i < 8; ++i) gd[i] = *(const u32x4*)(gbase + (size_t)((i >> 2) * 128 + (i & 3) * 16) * GP + 1024);
        }
        asm volatile("" ::: "memory");
#pragma unroll
        for (int ai = 0; ai < 2; ++ai)
#pragma unroll
            for (int m = 0; m < 4; ++m) {
                const size_t row = (size_t)(row0 + ai * 128 + m * 16);
                const u32x4 gnw = gn[ai * 4 + m];
                if (u.seg < 2) {
                    const u32x4 gdw = gd[ai * 4 + m];
#pragma unroll
                    for (int bj = 0; bj < 2; ++bj)
#pragma unroll
                        for (int n = 0; n < 2; ++n) { const f32x4 a_ = gate4(gnw[2 * bj + n]), d_ = gate4(gdw[2 * bj + n]); f32x4 r;
                            r[0] = a_[0] * fast_rcp(d_[0]); r[1] = a_[1] * fast_rcp(d_[1]); r[2] = a_[2] * fast_rcp(d_[2]); r[3] = a_[3] * fast_rcp(d_[3]);
                            acc[ai][bj][m][n] *= r; }
                } else {
                    bf16_t* mp = MERGED + row * DM + col;
#pragma unroll
                    for (int bj = 0; bj < 2; ++bj) {
                        const f32x4 v0 = acc[ai][bj][m][0] * gate4(gnw[2 * bj]) * (1.f / 255.f), v1 = acc[ai][bj][m][1] * gate4(gnw[2 * bj + 1]) * (1.f / 255.f);
                        u32x4 w; w.x = cvtpk(v0[0], v0[1]); w.y = cvtpk(v0[2], v0[3]); w.z = cvtpk(v1[0], v1[1]); w.w = cvtpk(v1[2], v1[3]);
                        *(u32x4*)(mp + 8 * bj) = w; }
                }
            }
    }
};
struct EpiOut {
    __device__ __forceinline__ bool reset_after(const Unit&) const { return true; }
    const float* X; float* OUT; bf16_t* X1B; float* SS;
    __device__ __forceinline__ void operator()(const Acc& acc, const Unit& u, int wr, int wc, int fr, int fq) const {
        const int row0 = u.pm * 256 + wr * 64 + fr, col = u.pn * 256 + wc * 64 + fq * 16;
        f32x4 xv[4][4];
#pragma unroll
        for (int i = 0; i < 4; ++i) { const float* xp = X + (size_t)(row0 + i * 16) * DM + col;
#pragma unroll
            for (int q = 0; q < 4; ++q) xv[i][q] = *(const f32x4*)(xp + 4 * q); }
        asm volatile("" ::: "memory");
#pragma unroll
        for (int i = 0; i < 8; ++i) {
            const int ai = i >> 2, m = i & 3;
            const size_t row = (size_t)(row0 + ai * 128 + m * 16);
            float ss = 0.f;
#pragma unroll
            for (int bj = 0; bj < 2; ++bj) {
                const f32x4 v0 = acc[ai][bj][m][0] + xv[i & 3][2 * bj], v1 = acc[ai][bj][m][1] + xv[i & 3][2 * bj + 1];
                ss += (v0[0] * v0[0] + v0[1] * v0[1]) + (v0[2] * v0[2] + v0[3] * v0[3]) + (v1[0] * v1[0] + v1[1] * v1[1]) + (v1[2] * v1[2] + v1[3] * v1[3]);
                u32x4 w; w.x = cvtpk(v0[0], v0[1]); w.y = cvtpk(v0[2], v0[3]); w.z = cvtpk(v1[0], v1[1]); w.w = cvtpk(v1[2], v1[3]);
                *(u32x4*)(X1B + row * DM + col + 8 * bj) = w;
            }
            if (i < 4) { const float* xp = X + (size_t)(row0 + 128 + i * 16) * DM + col;
#pragma unroll
                for (int q = 0; q < 4; ++q) xv[i][q] = *(const f32x4*)(xp + 4 * q); }
            ss = sum_fq(ss);
            if (fq == 0) atomicAdd(SS + row, ss);
        }
    }
};
struct EpiUp {
    __device__ __forceinline__ bool reset_after(const Unit&) const { return true; }
    const float* SS; const float* cw; const float* cb; bf16_t* ACT; float* UB;
    __device__ __forceinline__ void operator()(const Acc& acc, const Unit& u, int wr, int wc, int fr, int fq) const {
        const int T0 = u.pm * 256 + wr * 128 + fr * 8, grp = u.pm * 2 + wr, ch0 = u.pn * 128 + wc * 32 + fq * 8;
        const f32x4 sA = *(const f32x4*)(SS + T0), sB = *(const f32x4*)(SS + T0 + 4);
        const float r0 = rsqrtf(sA[0] * (1.f / 1024.f) + EPS), r1 = rsqrtf(sA[1] * (1.f / 1024.f) + EPS), r2 = rsqrtf(sA[2] * (1.f / 1024.f) + EPS), r3 = rsqrtf(sA[3] * (1.f / 1024.f) + EPS);
        const float r4 = rsqrtf(sB[0] * (1.f / 1024.f) + EPS), r5 = rsqrtf(sB[1] * (1.f / 1024.f) + EPS), r6 = rsqrtf(sB[2] * (1.f / 1024.f) + EPS), r7 = rsqrtf(sB[3] * (1.f / 1024.f) + EPS);
        bf16_t* actp = ACT + (size_t)T0 * DFF + ch0;
        float* ubp = UB + ((size_t)grp * DFF + ch0) * 8 + (fr == 15 ? 4 : 0);
#pragma unroll
        for (int n = 0; n < 2; ++n) {
            f32x4 cwa[3], cwg[3];
#pragma unroll
            for (int k = 0; k < 3; ++k) { cwa[k] = *(const f32x4*)(cw + k * UPN + ch0 + 4 * n); cwg[k] = *(const f32x4*)(cw + k * UPN + DFF + ch0 + 4 * n); }
            const f32x4 cba = *(const f32x4*)(cb + ch0 + 4 * n), cbg = *(const f32x4*)(cb + DFF + ch0 + 4 * n);
            unsigned pk[8][2];
#pragma unroll
            for (int jp = 0; jp < 2; ++jp) {
                float res[2][8];
#pragma unroll
                for (int jj = 0; jj < 2; ++jj) {
                    const int j = 2 * jp + jj;
                    const f32x2 w0 = (f32x2){cwa[0][j], cwg[0][j]}, w1 = (f32x2){cwa[1][j], cwg[1][j]}, w2 = (f32x2){cwa[2][j], cwg[2][j]}, bb = (f32x2){cba[j], cbg[j]};
                    const f32x2 x0 = (f32x2){acc[0][0][0][n][j], acc[0][1][0][n][j]} * r0, x1 = (f32x2){acc[0][0][1][n][j], acc[0][1][1][n][j]} * r1;
                    const f32x2 x2 = (f32x2){acc[0][0][2][n][j], acc[0][1][2][n][j]} * r2, x3 = (f32x2){acc[0][0][3][n][j], acc[0][1][3][n][j]} * r3;
                    const f32x2 x4 = (f32x2){acc[1][0][0][n][j], acc[1][1][0][n][j]} * r4, x5 = (f32x2){acc[1][0][1][n][j], acc[1][1][1][n][j]} * r5;
                    const f32x2 x6 = (f32x2){acc[1][0][2][n][j], acc[1][1][2][n][j]} * r6, x7 = (f32x2){acc[1][0][3][n][j], acc[1][1][3][n][j]} * r7;
                    const f32x2 xm2 = (f32x2){dpp_shr1(x6[0]), dpp_shr1(x6[1])}, xm1 = (f32x2){dpp_shr1(x7[0]), dpp_shr1(x7[1])};
                    if (fr == 0) *(f32x4*)(ubp + (4 * n + j) * 8) = (f32x4){x0[0], x0[1], x1[0], x1[1]};
                    if (fr == 15) *(f32x4*)(ubp + (4 * n + j) * 8) = (f32x4){x6[0], x6[1], x7[0], x7[1]};
#define UPC(r, p2, p1, p0) do { const f32x2 c_ = w0 * (p2) + (w1 * (p1) + (w2 * (p0) + bb)); res[jj][r] = c_[0] * sigmoidf_(c_[0]) * c_[1]; } while (0)
                    UPC(0, xm2, xm1, x0); UPC(1, xm1, x0, x1); UPC(2, x0, x1, x2); UPC(3, x1, x2, x3);
                    UPC(4, x2, x3, x4); UPC(5, x3, x4, x5); UPC(6, x4, x5, x6); UPC(7, x5, x6, x7);
#undef UPC
                }
#pragma unroll
                for (int r = 0; r < 8; ++r) pk[r][jp] = cvtpk(res[0][r], res[1][r]);
            }
#pragma unroll
            for (int r = 0; r < 8; ++r) {
                if (fr == 0 && r < 2) continue;
                *(u32x2*)(actp + (size_t)r * DFF + 4 * n) = (u32x2){pk[r][0], pk[r][1]};
            }
        }
    }
};
struct EpiDown {
    __device__ __forceinline__ bool reset_after(const Unit&) const { return true; }
    float* OUT; const bf16_t* X1B;
    __device__ __forceinline__ void operator()(const Acc& acc, const Unit& u, int wr, int wc, int fr, int fq) const {
        const int row0 = u.pm * 256 + wr * 64 + fr, col = u.pn * 256 + wc * 64 + fq * 16;
        u32x4 t[8][2];
#pragma unroll
        for (int i = 0; i < 8; ++i) { const size_t off = (size_t)(row0 + (i >> 2) * 128 + (i & 3) * 16) * DM + col; t[i][0] = *(const u32x4*)(X1B + off); t[i][1] = *(const u32x4*)(X1B + off + 8); }
        asm volatile("" ::: "memory");
#pragma unroll
        for (int ai = 0; ai < 2; ++ai)
#pragma unroll
            for (int m = 0; m < 4; ++m) {
                const size_t off = (size_t)(row0 + ai * 128 + m * 16) * DM + col;
                float* op = OUT + off;
#pragma unroll
                for (int bj = 0; bj < 2; ++bj) {
                    const u32x4 tw = t[ai * 4 + m][bj];
                    f32x4 v0 = acc[ai][bj][m][0], v1 = acc[ai][bj][m][1];
                    v0[0] += bflo(tw.x); v0[1] += bfhi(tw.x); v0[2] += bflo(tw.y); v0[3] += bfhi(tw.y);
                    v1[0] += bflo(tw.z); v1[1] += bfhi(tw.z); v1[2] += bflo(tw.w); v1[3] += bfhi(tw.w);
                    *(f32x4*)(op + 8 * bj) = v0; *(f32x4*)(op + 8 * bj + 4) = v1; }
            }
    }
};

struct AttnP {
    const bf16_t* QK; const bf16_t* VT; const bf16_t* MK; const bf16_t* MVT; const float* C2; bf16_t* O; float* S0;
    const float* lq1; const float* lk1; const float* lq2; const float* lk2; const float* subln; const float* mqn; const float* mkn; const float* GN;
};
__device__ __forceinline__ float max3f_(float a, float b, float c) { float r; asm("v_max3_f32 %0, %1, %2, %3" : "=v"(r) : "v"(a), "v"(b), "v"(c)); return r; }
constexpr int AT_KOFF = 0, AT_VOFF = 17408, AT_COFF = 35840, AT_BUF = 36096, AT_UNITW = 3 * AT_BUF;

template <int KIND>
__device__ __forceinline__ void attn_unit(LAS unsigned char* lds, const AttnP& P, int b, int head, int qb) {
    constexpr int DK = KIND == 2 ? 128 : 64, DV = KIND == 1 ? 64 : 128, NST = DK / 16, NDB = DV / 32;
    constexpr int KPITCH = DK * 2 + 16, VPITCH = 144;
    constexpr int NPASS = KIND == 0 ? 2 : 1;
    constexpr int KLD = DK / 64, VLD = DV / 64;
    int tid = threadIdx.x; asm volatile("" : "+v"(tid));
    const int lane = tid & 63, wid = __builtin_amdgcn_readfirstlane(tid >> 6), r32 = lane & 31, h = lane >> 5;
    const int q0 = qb * 256, qrow = q0 + wid * 32 + r32;
    const size_t tok0 = (size_t)b * SEQ;
    const int nkt = KIND == 2 ? 4 : (q0 + 256) / 64;
    const int wlast = KIND == 2 ? 3 : (q0 + wid * 32) / 64;
    float lam = 0.f;
    if (KIND == 0) {
        float v1 = P.lq1[lane] * P.lk1[lane], v2 = P.lq2[lane] * P.lk2[lane];
        v1 = wave_sum(v1); v2 = wave_sum(v2);
        lam = __expf(v1) - __expf(v2) + 0.2f;
    }
    const float sl2 = KIND == 0 ? LOG2E * exp2f(-2.f * (float)(head + 1)) : 0.f;
    int nit = nkt, ktw = 0;
    if (KIND == 0) {
        float gq = fabsf(P.GN[lane]), gk = fabsf(P.GN[64 + lane]);
#pragma unroll
        for (int o = 1; o < 64; o <<= 1) { gq = fmaxf(gq, __shfl_xor(gq, o)); gk = fmaxf(gk, __shfl_xor(gk, o)); }
        const float B = 1.03f * 64.f * gq * gk;
        const float dmax = (B + 134.f) / sl2;
        int ktm = (int)ceilf(((float)(q0 - 63) - dmax) * (1.f / 64.f));
        ktm = ktm < 0 ? 0 : ktm;
        nit = __builtin_amdgcn_readfirstlane(nkt - ktm);
        if (nit < 1) nit = 1;
        int kw = (int)ceilf(((float)(q0 + wid * 32 - 63) - dmax) * (1.f / 64.f));
        ktw = __builtin_amdgcn_readfirstlane(kw < 0 ? 0 : kw);
    }
#pragma unroll 1
    for (int pass = 0; pass < NPASS; ++pass) {
        const bf16_t *Qp, *Kp, *VTp; int kpitch, vtpitch;
        if (KIND == 0) { Qp = P.QK + tok0 * QKP + head * 128 + pass * 64; Kp = P.QK + tok0 * QKP + 512 + head * 128 + pass * 64; kpitch = QKP; VTp = P.VT + (size_t)(head * 128) * NTOK + tok0; vtpitch = NTOK; }
        else if (KIND == 1) { Qp = P.QK + tok0 * QKP + 1024 + head * 64; Kp = P.QK + tok0 * QKP + 1536 + head * 64; kpitch = QKP; VTp = P.VT + (size_t)(512 + head * 64) * NTOK + tok0; vtpitch = NTOK; }
        else { Qp = P.QK + tok0 * QKP + 2048 + head * 128; Kp = P.MK + (size_t)(b * NMEM) * 512 + head * 128; kpitch = 512; VTp = P.MVT + (size_t)(head * 128) * NMTOK + b * NMEM; vtpitch = NMTOK; }
        bf16x8 qf[NST];
#pragma unroll
        for (int st = 0; st < NST; ++st) qf[st] = *(const bf16x8*)(Qp + (size_t)qrow * QKP + 16 * st + 8 * h);
        if (KIND == 2) {
            float ss = 0.f;
#pragma unroll
            for (int st = 0; st < NST; ++st)
#pragma unroll
                for (int j = 0; j < 8; ++j) { const float v = bf2f((unsigned short)qf[st][j]); ss += v * v; }
            ss += __shfl_xor(ss, 32);
            const float rs = rsqrtf(ss * (1.f / 128.f) + EPS) * (0.08838834764831845f * LOG2E);
#pragma unroll
            for (int st = 0; st < NST; ++st) {
                const f32x4 g0 = *(const f32x4*)(P.mqn + 16 * st + 8 * h), g1 = *(const f32x4*)(P.mqn + 16 * st + 8 * h + 4);
                u32x4 w;
                w.x = cvtpk(bf2f((unsigned short)qf[st][0]) * rs * g0[0], bf2f((unsigned short)qf[st][1]) * rs * g0[1]);
                w.y = cvtpk(bf2f((unsigned short)qf[st][2]) * rs * g0[2], bf2f((unsigned short)qf[st][3]) * rs * g0[3]);
                w.z = cvtpk(bf2f((unsigned short)qf[st][4]) * rs * g1[0], bf2f((unsigned short)qf[st][5]) * rs * g1[1]);
                w.w = cvtpk(bf2f((unsigned short)qf[st][6]) * rs * g1[2], bf2f((unsigned short)qf[st][7]) * rs * g1[3]);
                qf[st] = __builtin_bit_cast(bf16x8, w);
            }
        }
        float m_ref = 0.f, l_run = 0.f;
        f32x16 oT[NDB];
#pragma unroll
        for (int db = 0; db < NDB; ++db)
#pragma unroll
            for (int r = 0; r < 16; ++r) oT[db][r] = 0.f;
        u32x4 kreg[KLD], vreg[VLD]; float creg = 0.f;
#define AT_LOAD(kt) do { const int k0_ = (kt) * 64; \
        _Pragma("unroll") for (int i = 0; i < KLD; ++i) { const int idx = tid + 512 * i, row = idx / (DK / 8), chn = idx % (DK / 8); kreg[i] = *(const u32x4*)(Kp + (size_t)(k0_ + row) * kpitch + chn * 8); } \
        _Pragma("unroll") for (int i = 0; i < VLD; ++i) { const int idx = tid + 512 * i, row = idx >> 3, chn = idx & 7; vreg[i] = *(const u32x4*)(VTp + (size_t)row * vtpitch + k0_ + chn * 8); } \
        if (KIND == 1 && tid < 64) creg = P.C2[(size_t)(b * 8 + head) * SEQ + k0_ + tid]; } while (0)
#define AT_STORE(bufi) do { LAS unsigned char* bb = lds + (bufi) * AT_BUF; \
        _Pragma("unroll") for (int i = 0; i < KLD; ++i) { const int idx = tid + 512 * i, row = idx / (DK / 8), chn = idx % (DK / 8); u32x4 kv = kreg[i]; \
            if (KIND == 2) { float f[8]; f[0] = bflo(kv.x); f[1] = bfhi(kv.x); f[2] = bflo(kv.y); f[3] = bfhi(kv.y); f[4] = bflo(kv.z); f[5] = bfhi(kv.z); f[6] = bflo(kv.w); f[7] = bfhi(kv.w); \
                float ss = 0.f; _Pragma("unroll") for (int e = 0; e < 8; ++e) ss += f[e] * f[e]; \
                ss = row16_sum(ss); \
                const float rs = rsqrtf(ss * (1.f / 128.f) + EPS); const f32x4 g0 = *(const f32x4*)(P.mkn + chn * 8), g1 = *(const f32x4*)(P.mkn + chn * 8 + 4); \
                kv.x = cvtpk(f[0] * rs * g0[0], f[1] * rs * g0[1]); kv.y = cvtpk(f[2] * rs * g0[2], f[3] * rs * g0[3]); kv.z = cvtpk(f[4] * rs * g1[0], f[5] * rs * g1[1]); kv.w = cvtpk(f[6] * rs * g1[2], f[7] * rs * g1[3]); } \
            *(LAS u32x4*)(bb + AT_KOFF + row * KPITCH + chn * 16) = kv; } \
        _Pragma("unroll") for (int i = 0; i < VLD; ++i) { const int idx = tid + 512 * i, row = idx >> 3, chn = idx & 7; LAS unsigned char* vp_ = bb + AT_VOFF + row * VPITCH + (chn >> 1) * 32 + (chn & 1) * 8; \
            *(LAS u32x2*)vp_ = (u32x2){vreg[i].x, vreg[i].y}; *(LAS u32x2*)(vp_ + 16) = (u32x2){vreg[i].z, vreg[i].w}; } \
        if (KIND == 1 && tid < 64) *(LAS float*)(bb + AT_COFF + tid * 4) = creg; } while (0)
        AT_LOAD(nkt - 1); AT_STORE(0);
        __syncthreads();
#define AT_PV(bufp) do { const LAS unsigned char* vb_ = (bufp) + AT_VOFF + r32 * VPITCH + h * 16; \
        _Pragma("unroll") for (int dp = 0; dp < NDB / 2; ++dp) { bf16x8 va[2][4]; \
            _Pragma("unroll") for (int d2 = 0; d2 < 2; ++d2) _Pragma("unroll") for (int kk = 0; kk < 4; ++kk) va[d2][kk] = *(const LAS bf16x8*)(vb_ + (2 * dp + d2) * 32 * VPITCH + kk * 32); \
            __builtin_amdgcn_sched_barrier(0); \
            _Pragma("unroll") for (int kk = 0; kk < 4; ++kk) _Pragma("unroll") for (int d2 = 0; d2 < 2; ++d2) oT[2 * dp + d2] = __builtin_amdgcn_mfma_f32_32x32x16_bf16(va[d2][kk], pf[kk], oT[2 * dp + d2], 0, 0, 0); \
            __builtin_amdgcn_sched_barrier(0); } } while (0)
        const bool lateB = false;
        bool have_prev = false; int prev_buf = 0, bi = 0;
        bf16x8 pf[4];
#pragma unroll
        for (int i = 0; i < 4; ++i) pf[i] = (bf16x8){0, 0, 0, 0, 0, 0, 0, 0};
#pragma unroll 1
        for (int it = 0; it < nit; ++it) {
            const int kt = nkt - 1 - it;
            if (it + 1 < nit) AT_LOAD(kt - 1);
            if (lateB && have_prev) { AT_PV(lds + prev_buf * AT_BUF); }
            if (kt <= wlast && kt >= ktw) {
                const LAS unsigned char* buf = lds + bi * AT_BUF;
                const int k0 = kt * 64;
                f32x16 s0, s1;
                if (KIND == 0 && kt < wlast) {
                    const float nb = -m_ref - sl2 * (float)(qrow - k0 - 4 * h);
#pragma unroll
                    for (int r = 0; r < 16; ++r) { const float o = (float)((r & 3) + 8 * (r >> 2)); s0[r] = fmaf(sl2, o, nb); s1[r] = fmaf(sl2, o + 32.f, nb); }
                } else if (KIND == 1) {
                    const LAS float* cs = (const LAS float*)(buf + AT_COFF);
#pragma unroll
                    for (int g = 0; g < 4; ++g) { const f32x4 c0 = *(const LAS f32x4*)(cs + 8 * g + 4 * h), c1 = *(const LAS f32x4*)(cs + 32 + 8 * g + 4 * h);
#pragma unroll
                        for (int i = 0; i < 4; ++i) { s0[4 * g + i] = -m_ref - c0[i]; s1[4 * g + i] = -m_ref - c1[i]; } }
                } else {
#pragma unroll
                    for (int r = 0; r < 16; ++r) { s0[r] = -m_ref; s1[r] = -m_ref; }
                }
                const LAS unsigned char* kb_ = buf + AT_KOFF + r32 * KPITCH + h * 16;
#pragma unroll
                for (int sg = 0; sg < NST / 4; ++sg) {
                    bf16x8 ka[4][2];
#pragma unroll
                    for (int st = 0; st < 4; ++st) { ka[st][0] = *(const LAS bf16x8*)(kb_ + (4 * sg + st) * 32); ka[st][1] = *(const LAS bf16x8*)(kb_ + 32 * KPITCH + (4 * sg + st) * 32); }
                    __builtin_amdgcn_sched_barrier(0);
#pragma unroll
                    for (int st = 0; st < 4; ++st) {
                        s0 = __builtin_amdgcn_mfma_f32_32x32x16_bf16(ka[st][0], qf[4 * sg + st], s0, 0, 0, 0);
                        s1 = __builtin_amdgcn_mfma_f32_32x32x16_bf16(ka[st][1], qf[4 * sg + st], s1, 0, 0, 0);
                    }
                    __builtin_amdgcn_sched_barrier(0);
                }
                if (KIND == 1) {
                    if (kt == wlast) {
#pragma unroll
                        for (int r = 0; r < 16; ++r) { const int kv = k0 + (r & 3) + 8 * (r >> 2) + 4 * h; if (kv > qrow) s0[r] = -INFINITY; if (kv + 32 > qrow) s1[r] = -INFINITY; }
                    }
                }
                if (KIND == 0 && kt == wlast) {
                    const float dq = (float)(qrow - k0 - 4 * h);
#pragma unroll
                    for (int r = 0; r < 16; ++r) { const float o = (float)((r & 3) + 8 * (r >> 2)); s0[r] = fmaf(-sl2, fabsf(dq - o), s0[r]); s1[r] = fmaf(-sl2, fabsf(dq - o - 32.f), s1[r]); }
                }
                float mx = max3f_(s0[0], s1[0], s0[1]), mxb = max3f_(s1[1], s0[2], s1[2]);
#pragma unroll
                for (int r = 3; r < 15; r += 2) { mx = max3f_(mx, s0[r], s1[r]); mxb = max3f_(mxb, s0[r + 1], s1[r + 1]); }
                mx = max3f_(mx, s0[15], s1[15]); mx = max3f_(mx, mxb, mxb);
                { const auto rr = __builtin_amdgcn_permlane32_swap(__float_as_uint(mx), __float_as_uint(mx), false, false); mx = max3f_(__uint_as_float(rr[0]), __uint_as_float(rr[1]), __uint_as_float(rr[1])); }
                if (!(KIND == 0 && __all(mx < -134.f))) {
                if (__any(mx > 8.f)) {
                    const float dl = fmaxf(mx, 0.f), f = fast_exp2(-dl);
                    m_ref += dl; l_run *= f;
#pragma unroll
                    for (int r = 0; r < 16; ++r) { s0[r] -= dl; s1[r] -= dl; }
#pragma unroll
                    for (int db = 0; db < NDB; ++db)
#pragma unroll
                        for (int r = 0; r < 16; ++r) oT[db][r] *= f;
                }
                const LAS unsigned char* vb0_ = buf + AT_VOFF + r32 * VPITCH + h * 16;
                bf16x8 va0[2][4];
#pragma unroll
                for (int d2 = 0; d2 < 2; ++d2)
#pragma unroll
                    for (int kk = 0; kk < 4; ++kk) va0[d2][kk] = *(const LAS bf16x8*)(vb0_ + d2 * 32 * VPITCH + kk * 32);
                __builtin_amdgcn_sched_barrier(0);
                f32x2 rs2 = (f32x2){0.f, 0.f};
#pragma unroll
                for (int r = 0; r < 16; ++r) { s0[r] = fast_exp2(s0[r]); s1[r] = fast_exp2(s1[r]); }
#pragma unroll
                for (int r = 0; r < 16; r += 2) { rs2 += (f32x2){s0[r], s0[r + 1]}; rs2 += (f32x2){s1[r], s1[r + 1]}; }
                l_run += rs2[0] + rs2[1];
                { u32x4 w;
                  w.x = cvtpk(s0[0], s0[1]); w.y = cvtpk(s0[2], s0[3]); w.z = cvtpk(s0[4], s0[5]); w.w = cvtpk(s0[6], s0[7]); pf[0] = __builtin_bit_cast(bf16x8, w);
                  w.x = cvtpk(s0[8], s0[9]); w.y = cvtpk(s0[10], s0[11]); w.z = cvtpk(s0[12], s0[13]); w.w = cvtpk(s0[14], s0[15]); pf[1] = __builtin_bit_cast(bf16x8, w);
                  w.x = cvtpk(s1[0], s1[1]); w.y = cvtpk(s1[2], s1[3]); w.z = cvtpk(s1[4], s1[5]); w.w = cvtpk(s1[6], s1[7]); pf[2] = __builtin_bit_cast(bf16x8, w);
                  w.x = cvtpk(s1[8], s1[9]); w.y = cvtpk(s1[10], s1[11]); w.z = cvtpk(s1[12], s1[13]); w.w = cvtpk(s1[14], s1[15]); pf[3] = __builtin_bit_cast(bf16x8, w); }
                __builtin_amdgcn_sched_barrier(0);
#pragma unroll
                for (int kk = 0; kk < 4; ++kk)
#pragma unroll
                    for (int d2 = 0; d2 < 2; ++d2) oT[d2] = __builtin_amdgcn_mfma_f32_32x32x16_bf16(va0[d2][kk], pf[kk], oT[d2], 0, 0, 0);
                __builtin_amdgcn_sched_barrier(0);
                if (NDB == 4) {
                    bf16x8 va1[2][4];
#pragma unroll
                    for (int d2 = 0; d2 < 2; ++d2)
#pragma unroll
                        for (int kk = 0; kk < 4; ++kk) va1[d2][kk] = *(const LAS bf16x8*)(vb0_ + (2 + d2) * 32 * VPITCH + kk * 32);
                    __builtin_amdgcn_sched_barrier(0);
#pragma unroll
                    for (int kk = 0; kk < 4; ++kk)
#pragma unroll
                        for (int d2 = 0; d2 < 2; ++d2) oT[NDB - 2 + d2] = __builtin_amdgcn_mfma_f32_32x32x16_bf16(va1[d2][kk], pf[kk], oT[NDB - 2 + d2], 0, 0, 0);
                    __builtin_amdgcn_sched_barrier(0);
                }
                }
            }
            if (lateB) { have_prev = (kt <= wlast); prev_buf = bi; }
            const int bn = bi == 2 ? 0 : bi + 1;
            if (it + 1 < nit) AT_STORE(bn);
            bi = bn;
            __syncthreads();
        }
        if (lateB && have_prev) { AT_PV(lds + prev_buf * AT_BUF); }
        __syncthreads();
#undef AT_PV
#undef AT_LOAD
#undef AT_STORE
        const float l = l_run + __shfl_xor(l_run, 32), inv = 1.f / l;
        float* sp = P.S0 + (tok0 + qrow) * 512 + head * 128 + 4 * h;
        if (KIND == 0 && pass == 0) {
#pragma unroll
            for (int db = 0; db < NDB; ++db)
#pragma unroll
                for (int g = 0; g < 4; ++g) { f32x4 v; v[0] = oT[db][4 * g] * inv; v[1] = oT[db][4 * g + 1] * inv; v[2] = oT[db][4 * g + 2] * inv; v[3] = oT[db][4 * g + 3] * inv; *(f32x4*)(sp + 32 * db + 8 * g) = v; }
        } else {
            float rs = inv;
            if (KIND == 0) {
                float ss = 0.f; const float li = lam * inv;
#pragma unroll
                for (int db = 0; db < NDB; ++db)
#pragma unroll
                    for (int g = 0; g < 4; ++g) { const f32x4 o0 = *(const f32x4*)(sp + 32 * db + 8 * g);
#pragma unroll
                        for (int i = 0; i < 4; ++i) { const float v = o0[i] - li * oT[db][4 * g + i]; oT[db][4 * g + i] = v; ss += v * v; } }
                ss += __shfl_xor(ss, 32);
                rs = rsqrtf(ss * (1.f / 128.f) + EPS) * 0.8f;
            }
            const int obase = KIND == 0 ? 0 : (KIND == 1 ? 1 : 2);
            bf16_t* op = P.O + (size_t)obase * NTOK * 512 + (tok0 + qrow) * 512 + head * DV + 4 * h;
#pragma unroll
            for (int db = 0; db < NDB; ++db)
#pragma unroll
                for (int g = 0; g < 4; ++g) {
                    f32x4 mu = (f32x4){rs, rs, rs, rs};
                    if (KIND == 0) mu = mu * *(const f32x4*)(P.subln + 32 * db + 8 * g + 4 * h);
                    u32x2 w; w.x = cvtpk(oT[db][4 * g] * mu[0], oT[db][4 * g + 1] * mu[1]); w.y = cvtpk(oT[db][4 * g + 2] * mu[2], oT[db][4 * g + 3] * mu[3]);
                    *(u32x2*)(op + 32 * db + 8 * g) = w; }
        }
    }
}

__device__ __forceinline__ void attn_fx64(LAS unsigned char* lds, const AttnP& P, int b, int head, int qb) {
    constexpr int KPITCH = 144, VPITCH = 144;
    int tid = threadIdx.x; asm volatile("" : "+v"(tid));
    const int lane = tid & 63, wid = __builtin_amdgcn_readfirstlane(tid >> 6), r32 = lane & 31, h = lane >> 5;
    const int q0 = qb * 512, qA = q0 + wid * 64 + r32, qB = qA + 32;
    const size_t tok0 = (size_t)b * SEQ;
    const int nkt = (q0 + 512) / 64, wlast = (q0 >> 6) + wid;
    const bf16_t* Qp = P.QK + tok0 * QKP + 1024 + head * 64;
    const bf16_t* Kp = P.QK + tok0 * QKP + 1536 + head * 64;
    const bf16_t* VTp = P.VT + (size_t)(512 + head * 64) * NTOK + tok0;
    const float* C2p = P.C2 + (size_t)(b * 8 + head) * SEQ;
    bf16x8 qfA[4], qfB[4];
#pragma unroll
    for (int st = 0; st < 4; ++st) { qfA[st] = *(const bf16x8*)(Qp + (size_t)qA * QKP + 16 * st + 8 * h); qfB[st] = *(const bf16x8*)(Qp + (size_t)qB * QKP + 16 * st + 8 * h); }
    float mA = 0.f, mB = 0.f, lA = 0.f, lB = 0.f;
    f32x16 oA[2], oB[2];
#pragma unroll
    for (int d = 0; d < 2; ++d)
#pragma unroll
        for (int r = 0; r < 16; ++r) { oA[d][r] = 0.f; oB[d][r] = 0.f; }
    u32x4 kreg, vreg; float creg = 0.f;
    const int srow = tid >> 3, schn = tid & 7;
#define FX_LOAD(kt) do { const int k0_ = (kt) * 64; kreg = *(const u32x4*)(Kp + (size_t)(k0_ + srow) * QKP + schn * 8); vreg = *(const u32x4*)(VTp + (size_t)srow * NTOK + k0_ + schn * 8); \
        if (tid < 64) creg = C2p[k0_ + tid]; } while (0)
#define FX_STORE(bufi) do { LAS unsigned char* bb = lds + (bufi) * AT_BUF; *(LAS u32x4*)(bb + AT_KOFF + srow * KPITCH + schn * 16) = kreg; \
        LAS unsigned char* vp_ = bb + AT_VOFF + srow * VPITCH + (schn >> 1) * 32 + (schn & 1) * 8; *(LAS u32x2*)vp_ = (u32x2){vreg.x, vreg.y}; *(LAS u32x2*)(vp_ + 16) = (u32x2){vreg.z, vreg.w}; \
        if (tid < 64) *(LAS float*)(bb + AT_COFF + tid * 4) = creg; } while (0)
#define FX_MAX(MX, S0, S1) do { float m_ = max3f_(S0[0], S1[0], S0[1]), n_ = max3f_(S1[1], S0[2], S1[2]); \
        _Pragma("unroll") for (int r = 3; r < 15; r += 2) { m_ = max3f_(m_, S0[r], S1[r]); n_ = max3f_(n_, S0[r + 1], S1[r + 1]); } \
        m_ = max3f_(m_, S0[15], S1[15]); m_ = max3f_(m_, n_, n_); \
        const auto rr_ = __builtin_amdgcn_permlane32_swap(__float_as_uint(m_), __float_as_uint(m_), false, false); MX = max3f_(__uint_as_float(rr_[0]), __uint_as_float(rr_[1]), __uint_as_float(rr_[1])); } while (0)
#define FX_EXP(S0, S1, L, PF) do { f32x2 rs2 = (f32x2){0.f, 0.f}; \
        _Pragma("unroll") for (int r = 0; r < 16; ++r) { S0[r] = fast_exp2(S0[r]); S1[r] = fast_exp2(S1[r]); } \
        _Pragma("unroll") for (int r = 0; r < 16; r += 2) { rs2 += (f32x2){S0[r], S0[r + 1]}; rs2 += (f32x2){S1[r], S1[r + 1]}; } \
        L += rs2[0] + rs2[1]; u32x4 w; \
        w.x = cvtpk(S0[0], S0[1]); w.y = cvtpk(S0[2], S0[3]); w.z = cvtpk(S0[4], S0[5]); w.w = cvtpk(S0[6], S0[7]); PF[0] = __builtin_bit_cast(bf16x8, w); \
        w.x = cvtpk(S0[8], S0[9]); w.y = cvtpk(S0[10], S0[11]); w.z = cvtpk(S0[12], S0[13]); w.w = cvtpk(S0[14], S0[15]); PF[1] = __builtin_bit_cast(bf16x8, w); \
        w.x = cvtpk(S1[0], S1[1]); w.y = cvtpk(S1[2], S1[3]); w.z = cvtpk(S1[4], S1[5]); w.w = cvtpk(S1[6], S1[7]); PF[2] = __builtin_bit_cast(bf16x8, w); \
        w.x = cvtpk(S1[8], S1[9]); w.y = cvtpk(S1[10], S1[11]); w.z = cvtpk(S1[12], S1[13]); w.w = cvtpk(S1[14], S1[15]); PF[3] = __builtin_bit_cast(bf16x8, w); } while (0)
    FX_LOAD(nkt - 1); FX_STORE(0);
    __syncthreads();
#pragma unroll 1
    for (int it = 0; it < nkt; ++it) {
        const int kt = nkt - 1 - it;
        if (it + 1 < nkt) FX_LOAD(kt - 1);
        if (kt <= wlast) {
            const LAS unsigned char* buf = lds + (it & 1) * AT_BUF;
            const int k0 = kt * 64;
            f32x16 a0, a1, b0, b1;
            {
                const LAS float* cs = (const LAS float*)(buf + AT_COFF);
#pragma unroll
                for (int g = 0; g < 4; ++g) { const f32x4 c0 = *(const LAS f32x4*)(cs + 8 * g + 4 * h), c1 = *(const LAS f32x4*)(cs + 32 + 8 * g + 4 * h);
#pragma unroll
                    for (int i = 0; i < 4; ++i) { a0[4 * g + i] = -mA - c0[i]; a1[4 * g + i] = -mA - c1[i]; b0[4 * g + i] = -mB - c0[i]; b1[4 * g + i] = -mB - c1[i]; } }
            }
            {
                const LAS unsigned char* kb_ = buf + AT_KOFF + r32 * KPITCH + h * 16;
                bf16x8 ka[4][2];
#pragma unroll
                for (int st = 0; st < 4; ++st) { ka[st][0] = *(const LAS bf16x8*)(kb_ + st * 32); ka[st][1] = *(const LAS bf16x8*)(kb_ + 32 * KPITCH + st * 32); }
                __builtin_amdgcn_sched_barrier(0);
#pragma unroll
                for (int st = 0; st < 4; ++st) {
                    a0 = __builtin_amdgcn_mfma_f32_32x32x16_bf16(ka[st][0], qfA[st], a0, 0, 0, 0);
                    b0 = __builtin_amdgcn_mfma_f32_32x32x16_bf16(ka[st][0], qfB[st], b0, 0, 0, 0);
                    a1 = __builtin_amdgcn_mfma_f32_32x32x16_bf16(ka[st][1], qfA[st], a1, 0, 0, 0);
                    b1 = __builtin_amdgcn_mfma_f32_32x32x16_bf16(ka[st][1], qfB[st], b1, 0, 0, 0);
                }
                __builtin_amdgcn_sched_barrier(0);
            }
            if (kt == wlast) {
#pragma unroll
                for (int r = 0; r < 16; ++r) { const int kv = k0 + (r & 3) + 8 * (r >> 2) + 4 * h;
                    if (kv > qA) a0[r] = -INFINITY; if (kv + 32 > qA) a1[r] = -INFINITY; if (kv > qB) b0[r] = -INFINITY; if (kv + 32 > qB) b1[r] = -INFINITY; }
            }
            float mxA, mxB; FX_MAX(mxA, a0, a1); FX_MAX(mxB, b0, b1);
            if (!__all(fmaxf(mxA, mxB) < -134.f)) {
            if (__any(fmaxf(mxA, mxB) > 8.f)) {
                const float dA = fmaxf(mxA, 0.f), dB = fmaxf(mxB, 0.f), fA = fast_exp2(-dA), fB = fast_exp2(-dB);
                mA += dA; mB += dB; lA *= fA; lB *= fB;
#pragma unroll
                for (int r = 0; r < 16; ++r) { a0[r] -= dA; a1[r] -= dA; b0[r] -= dB; b1[r] -= dB; }
#pragma unroll
                for (int d = 0; d < 2; ++d)
#pragma unroll
                    for (int r = 0; r < 16; ++r) { oA[d][r] *= fA; oB[d][r] *= fB; }
            }
            const LAS unsigned char* vb_ = buf + AT_VOFF + r32 * VPITCH + h * 16;
            bf16x8 va[2][4];
#pragma unroll
            for (int d2 = 0; d2 < 2; ++d2)
#pragma unroll
                for (int kk = 0; kk < 4; ++kk) va[d2][kk] = *(const LAS bf16x8*)(vb_ + d2 * 32 * VPITCH + kk * 32);
            __builtin_amdgcn_sched_barrier(0);
            bf16x8 pA[4], pB[4];
            FX_EXP(a0, a1, lA, pA);
            __builtin_amdgcn_sched_barrier(0);
#pragma unroll
            for (int kk = 0; kk < 4; ++kk)
#pragma unroll
                for (int d2 = 0; d2 < 2; ++d2) oA[d2] = __builtin_amdgcn_mfma_f32_32x32x16_bf16(va[d2][kk], pA[kk], oA[d2], 0, 0, 0);
            __builtin_amdgcn_sched_barrier(0);
            FX_EXP(b0, b1, lB, pB);
            __builtin_amdgcn_sched_barrier(0);
#pragma unroll
            for (int kk = 0; kk < 4; ++kk)
#pragma unroll
                for (int d2 = 0; d2 < 2; ++d2) oB[d2] = __builtin_amdgcn_mfma_f32_32x32x16_bf16(va[d2][kk], pB[kk], oB[d2], 0, 0, 0);
            __builtin_amdgcn_sched_barrier(0);
            }
        }
        if (it + 1 < nkt) FX_STORE((it + 1) & 1);
        __syncthreads();
    }
#undef FX_LOAD
#undef FX_STORE
#undef FX_MAX
#undef FX_EXP
    const float iA = 1.f / (lA + __shfl_xor(lA, 32)), iB = 1.f / (lB + __shfl_xor(lB, 32));
    bf16_t* opA = P.O + (size_t)NTOK * 512 + (tok0 + qA) * 512 + head * 64 + 4 * h;
    bf16_t* opB = opA + (size_t)32 * 512;
#pragma unroll
    for (int db = 0; db < 2; ++db)
#pragma unroll
        for (int g = 0; g < 4; ++g) {
            u32x2 w; w.x = cvtpk(oA[db][4 * g] * iA, oA[db][4 * g + 1] * iA); w.y = cvtpk(oA[db][4 * g + 2] * iA, oA[db][4 * g + 3] * iA); *(u32x2*)(opA + 32 * db + 8 * g) = w;
            u32x2 x; x.x = cvtpk(oB[db][4 * g] * iB, oB[db][4 * g + 1] * iB); x.y = cvtpk(oB[db][4 * g + 2] * iB, oB[db][4 * g + 3] * iB); *(u32x2*)(opB + 32 * db + 8 * g) = x; }
}

__device__ __forceinline__ void decode_unit(int idx, int& kind, int& qb, int& sub) {
    if (idx < 320) { kind = 0; qb = 7 - idx / 64; sub = idx % 64; }
    else if (idx < 448) { kind = 1; qb = 3; sub = idx - 320; }
    else if (idx < 512) { kind = 0; qb = 2; sub = idx - 448; }
    else if (idx < 640) { kind = 1; qb = 2; sub = idx - 512; }
    else if (idx < 704) { kind = 0; qb = 1; sub = idx - 640; }
    else if (idx < 832) { kind = 1; qb = 1; sub = idx - 704; }
    else if (idx < 896) { kind = 0; qb = 0; sub = idx - 832; }
    else if (idx < 1024) { kind = 1; qb = 0; sub = idx - 896; }
    else { kind = 2; const int t = idx - 1024; qb = t / 64; sub = t % 64; }
}
constexpr int N_ATT_UNITS = 1536;

__device__ __forceinline__ int inv_perm16(int L) { return ((L >> 3) & 1) * 128 + (L >> 6) * 32 + ((L >> 2) & 1) * 16 + ((L >> 4) & 3) * 4 + (L & 3); }
__device__ __forceinline__ int src_of(int mat, int lg) {
    switch (mat) {
    case 0: if (lg < 1024) return lg; if (lg < 2048) return 1536 + (lg - 1024); if (lg < 2560) return 3080 + (lg - 2048); return 3592 + (lg - 2560);
    case 1: return lg < 512 ? 1024 + lg : 2560 + (lg - 512);
    case 3: return 512 + lg;
    default: return lg;
    }
}
__device__ __forceinline__ int dst_of(int mat, int lg) {
    switch (mat) {
    case 1: case 3: return lg;
    case 8: { const int bj = lg >= DFF ? 1 : 0, chl = lg - bj * DFF, pn = chl >> 7, co = chl & 127;
              return pn * 256 + bj * 128 + (co >> 5) * 32 + ((co >> 2) & 1) * 16 + ((co >> 3) & 3) * 4 + (co & 3); }
    default: return (lg & ~255) + inv_perm16(lg & 255);
    }
}
__device__ __forceinline__ void transpose_item(const float* W, int K, int Npitch, bf16_t* WT, int nblk, int mat, const float* rowgain, LAS float* scr, int item, int lane) {
    const int kb = item / nblk, nb = item % nblk, k0 = 64 * kb, l0 = 32 * nb;
    const int sc = src_of(mat, l0 + (lane & 31));
    float t[32];
#pragma unroll
    for (int i = 0; i < 32; ++i) t[i] = W[(size_t)(k0 + 2 * i + (lane >> 5)) * Npitch + sc];
#pragma unroll
    for (int i = 0; i < 32; ++i) { const int kk = 2 * i + (lane >> 5); float v = t[i]; if (rowgain) v *= rowgain[k0 + kk]; scr[kk * 33 + (lane & 31)] = v; }
    asm volatile("s_waitcnt lgkmcnt(0)" ::: "memory");
    const int c = lane & 7;
#pragma unroll
    for (int j = 0; j < 4; ++j) { const int n = (lane >> 3) + 8 * j; const LAS float* sp = scr + (8 * c) * 33 + n;
        u32x4 o; o.x = cvtpk(sp[0 * 33], sp[1 * 33]); o.y = cvtpk(sp[2 * 33], sp[3 * 33]); o.z = cvtpk(sp[4 * 33], sp[5 * 33]); o.w = cvtpk(sp[6 * 33], sp[7 * 33]);
        *(u32x4*)(WT + (size_t)dst_of(mat, l0 + n) * K + k0 + 8 * c) = o; }
    asm volatile("s_waitcnt lgkmcnt(0)" ::: "memory");
}

#define XB_TMO      128
#define XB_XCNT(j)  (256  + 64 * (j))
#define XB_XSUB(j)  (1280 + 64 * (j))
#define XB_XGEN(j)  (2304 + 64 * (j))
#define XB_TOP      3328
#define XB_TOPGEN   3392
#define XCD_BAR_WORDS 3456
#define XB_SPIN_CAP (1u << 22)
__device__ __forceinline__ unsigned xb_ld(unsigned* p)              { return __hip_atomic_load(p, __ATOMIC_RELAXED, __HIP_MEMORY_SCOPE_AGENT); }
__device__ __forceinline__ unsigned xb_add(unsigned* p, unsigned v) { return __hip_atomic_fetch_add(p, v, __ATOMIC_RELAXED, __HIP_MEMORY_SCOPE_AGENT); }
__device__ __forceinline__ unsigned xb_xcc_id() { return (unsigned)__builtin_amdgcn_s_getreg((3 << 11) | 20) & 0xFu; }
#define XB_SPIN(cond, bar) do { unsigned _sp = 0; while (cond) { __builtin_amdgcn_s_sleep(1); \
    if ((++_sp & 255u) == 0u) { if (xb_ld(&(bar)[XB_TMO])) break; if (_sp > XB_SPIN_CAP) { atomicAdd(&(bar)[XB_TMO], 1u); break; } } } } while (0)
struct XcdBarrier { unsigned* bar; unsigned x; volatile LAS unsigned* st; };
__device__ __forceinline__ XcdBarrier xcd_barrier_post(unsigned* bar, volatile LAS unsigned* st) {
    XcdBarrier b; b.bar = bar; b.x = xb_xcc_id(); b.st = st;
    if (threadIdx.x == 0) (void)xb_add(&bar[XB_XCNT(b.x)], 1u);
    return b;
}
__device__ __forceinline__ void xcd_barrier_complete(unsigned* bar, unsigned x, unsigned& nloc, unsigned& nx) {
    const unsigned G = gridDim.x * gridDim.y * gridDim.z;
    unsigned sum, cnt, mine, sp = 0u;
    for (;;) {
        sum = 0u; cnt = 0u; mine = 0u;
#pragma unroll
        for (unsigned j = 0; j < 16; ++j) { const unsigned c = xb_ld(&bar[XB_XCNT(j)]); sum += c; cnt += (c > 0u) ? 1u : 0u; mine = (j == x) ? c : mine; }
        if (sum == G) break;
        __builtin_amdgcn_s_sleep(1);
        if ((++sp & 255u) == 0u) { if (xb_ld(&bar[XB_TMO])) break; if (sp > XB_SPIN_CAP) { atomicAdd(&bar[XB_TMO], 1u); break; } }
    }
    nloc = mine > 0u ? mine : 1u; nx = cnt > 0u ? cnt : 1u;
}
__device__ __forceinline__ void xcd_barrier(const XcdBarrier& b) {
    asm volatile("s_waitcnt vmcnt(0)" ::: "memory");
    __syncthreads();
    if (threadIdx.x == 0) {
        unsigned* bar = b.bar;
        __builtin_amdgcn_s_waitcnt(0);
        unsigned nloc = b.st[0], nx = b.st[1];
        if (nloc == 0u) { xcd_barrier_complete(bar, b.x, nloc, nx); b.st[0] = nloc; b.st[1] = nx; }
        const unsigned old = xb_add(&bar[XB_XSUB(b.x)], 1u);
        const unsigned gen = old / nloc;
        if (old + 1u == (gen + 1u) * nloc) {
            __builtin_amdgcn_fence(__ATOMIC_RELEASE, "agent");
            asm volatile("s_waitcnt vmcnt(0)" ::: "memory");
            const unsigned og = xb_add(&bar[XB_TOP], 1u);
            const unsigned tg = og / nx;
            if (og + 1u == (tg + 1u) * nx) xb_add(&bar[XB_TOPGEN], 1u);
            else XB_SPIN(xb_ld(&bar[XB_TOPGEN]) == tg, bar);
            __builtin_amdgcn_fence(__ATOMIC_ACQUIRE, "agent");
            xb_add(&bar[XB_XGEN(b.x)], 1u);
            asm volatile("s_waitcnt vmcnt(0)" ::: "memory");
        } else {
            XB_SPIN(xb_ld(&bar[XB_XGEN(b.x)]) == gen, bar);
            __builtin_amdgcn_fence(__ATOMIC_ACQUIRE, "agent");
            asm volatile("s_waitcnt vmcnt(0)" ::: "memory");
        }
    }
    __syncthreads();
}

struct Args { const float* in[28]; float* out; unsigned char* ws; int ph_lo, ph_hi; };

__global__ void __launch_bounds__(512, 2) mega_fwd(Args a) {
    extern __shared__ __attribute__((aligned(16))) unsigned char lds_raw[];
    LAS unsigned char* lds = (LAS unsigned char*)lds_raw;
    const int tid = threadIdx.x, lane = tid & 63, wid = __builtin_amdgcn_readfirstlane(tid >> 6);
    const int G = gridDim.x, bx = blockIdx.x;
    unsigned char* ws = a.ws;
    const int lo = a.ph_lo, hi = a.ph_hi;
#define IN(k) (lo <= (k) && (k) < hi)
#define SYNC_AFTER(k) do { if (IN(k) && IN((k) + 1)) { xcd_barrier(xbar); } } while (0)
    { volatile LAS unsigned* st_ = (volatile LAS unsigned*)(lds + LDS_BYTES - 16); if (tid < 4) st_[tid] = 0u; }
    __syncthreads();
    const XcdBarrier xbar = xcd_barrier_post((unsigned*)(ws + WS_CTL) + 2048, (volatile LAS unsigned*)(lds + LDS_BYTES - 16));
    if (hi > 100) cg::this_grid().sync();
    const float* x = a.in[0];
    bf16_t* H = (bf16_t*)a.out;
    bf16_t* VT = (bf16_t*)((unsigned char*)a.out + 64 * MiB);
    bf16_t* MH = (bf16_t*)(ws + WS_MH);
    float* LOGF = (float*)(ws + WS_LOGF); float* C2 = (float*)(ws + WS_C2); float* SS = (float*)(ws + WS_SS);
    unsigned* CTL = (unsigned*)(ws + WS_CTL);

    if (IN(0)) {
        const int gw = bx * NWAVES + wid, NGW = G * NWAVES;
        LAS float* wl = (LAS float*)lds;
        for (int i = tid; i < 1024 * 8; i += 512) { const int k = i >> 3, g = i & 7; const int j = k >> 8, ln = (k >> 2) & 63, e = k & 3;
            wl[((j * 4 + e) * 64 + ln) * 8 + g] = a.in[3][(size_t)k * INCOLS + 3072 + g]; }
        for (int i = bx * 512 + tid; i < NTOK; i += G * 512) SS[i] = 0.f;
        if (bx == 0 && tid < 64) { float* GN = (float*)(ws + WS_CTL + 4096); const float qs = 0.125f * LOG2E;
            GN[tid] = a.in[5][tid] * qs; GN[64 + tid] = a.in[6][tid]; GN[128 + tid] = a.in[12][tid] * qs; GN[192 + tid] = a.in[13][tid]; }
        __syncthreads();
        LAS float* scr = (LAS float*)(lds + 32768 + wid * 8448);
        constexpr int I0 = 2816, I1 = I0 + 512, I2 = I1 + 256, I3 = I2 + 256, I4 = I3 + 256, I5 = I4 + 256, I6 = I5 + 256, I7 = I6 + 512, I8 = I7 + 2816, I9 = I8 + 1408;
        for (int it = gw; it < I9; it += NGW) {
            if (it < I0) transpose_item(a.in[3], 1024, INCOLS, (bf16_t*)(ws + WS_W1), 176, 0, nullptr, scr, it, lane);
            else if (it < I1) transpose_item(a.in[3], 1024, INCOLS, (bf16_t*)(ws + WS_WV), 32, 1, nullptr, scr, it - I0, lane);
            else if (it < I2) transpose_item(a.in[16], 1024, 1024, (bf16_t*)(ws + WS_WMK), 16, 2, nullptr, scr, it - I1, lane);
            else if (it < I3) transpose_item(a.in[16], 1024, 1024, (bf16_t*)(ws + WS_WMV), 16, 3, nullptr, scr, it - I2, lane);
            else if (it < I4) transpose_item(a.in[19], 512, 1024, (bf16_t*)(ws + WS_WBR), 32, 4, nullptr, scr, it - I3, lane);
            else if (it < I5) transpose_item(a.in[20], 512, 1024, (bf16_t*)(ws + WS_WBR) + 1024 * 512, 32, 4, nullptr, scr, it - I4, lane);
            else if (it < I6) transpose_item(a.in[21], 512, 1024, (bf16_t*)(ws + WS_WBR) + 2 * 1024 * 512, 32, 4, nullptr, scr, it - I5, lane);
            else if (it < I7) transpose_item(a.in[22], 1024, 1024, (bf16_t*)(ws + WS_WOUT), 32, 4, nullptr, scr, it - I6, lane);
            else if (it < I8) transpose_item(a.in[24], 1024, UPN, (bf16_t*)(ws + WS_WUP), 176, 8, a.in[23], scr, it - I7, lane);
            else transpose_item(a.in[27], DFF, 1024, (bf16_t*)(ws + WS_WDN), 32, 4, nullptr, scr, it - I8, lane);
        }
        f32x4 gv[4];
#pragma unroll
        for (int j = 0; j < 4; ++j) gv[j] = ((const f32x4*)a.in[2])[lane + 64 * j];
        const float fbias = a.in[14][lane & 7];
        {
        f32x4 nx[4];
        if (gw < NTOK) { const f32x4* xr = (const f32x4*)(x + (size_t)gw * DM) + lane;
#pragma unroll
            for (int j = 0; j < 4; ++j) nx[j] = xr[64 * j]; }
        for (int m = gw; m < NTOK; m += NGW) {
            f32x4 v[4]; float s = 0.f;
#pragma unroll
            for (int j = 0; j < 4; ++j) v[j] = nx[j];
            if (m + NGW < NTOK) { const f32x4* xr = (const f32x4*)(x + (size_t)(m + NGW) * DM) + lane;
#pragma unroll
                for (int j = 0; j < 4; ++j) nx[j] = xr[64 * j]; }
#pragma unroll
            for (int j = 0; j < 4; ++j) s += (v[j][0] * v[j][0] + v[j][1] * v[j][1]) + (v[j][2] * v[j][2] + v[j][3] * v[j][3]);
            const float rstd = rsqrtf(wave_sum(s) * (1.f / DM) + EPS);
            unsigned long long* o8 = (unsigned long long*)(H + (size_t)m * DM) + lane;
            float fg[8];
#pragma unroll
            for (int g = 0; g < 8; ++g) fg[g] = 0.f;
#pragma unroll
            for (int j = 0; j < 4; ++j) {
                v[j] = v[j] * rstd * gv[j];
                o8[64 * j] = (unsigned long long)cvtpk(v[j][0], v[j][1]) | ((unsigned long long)cvtpk(v[j][2], v[j][3]) << 32);
#pragma unroll
                for (int e = 0; e < 4; ++e) { const LAS f32x4* wp = (const LAS f32x4*)(wl + ((j * 4 + e) * 64 + lane) * 8); const f32x4 w0 = wp[0], w1 = wp[1];
                    fg[0] += v[j][e] * w0[0]; fg[1] += v[j][e] * w0[1]; fg[2] += v[j][e] * w0[2]; fg[3] += v[j][e] * w0[3];
                    fg[4] += v[j][e] * w1[0]; fg[5] += v[j][e] * w1[1]; fg[6] += v[j][e] * w1[2]; fg[7] += v[j][e] * w1[3]; }
            }
            float mine = 0.f;
#pragma unroll
            for (int g = 0; g < 8; ++g) { const float t = wave_sum(fg[g]); if ((lane & 7) == g) mine = t; }
            if (lane < 8) { const float z = mine + fbias; const float lf = fminf(z, 0.f) - log1pf(__expf(-fabsf(z)));
                LOGF[(size_t)((m >> 11) * 8 + lane) * SEQ + (m & 2047)] = lf; }
        }
        }
#pragma unroll
        for (int j = 0; j < 4; ++j) gv[j] = ((const f32x4*)a.in[15])[lane + 64 * j];
        for (int m = gw; m < NMTOK; m += NGW) {
            const f32x4* xr = (const f32x4*)(a.in[1] + (size_t)m * DM) + lane;
            f32x4 v[4]; float s = 0.f;
#pragma unroll
            for (int j = 0; j < 4; ++j) { v[j] = xr[64 * j]; s += (v[j][0] * v[j][0] + v[j][1] * v[j][1]) + (v[j][2] * v[j][2] + v[j][3] * v[j][3]); }
            const float rstd = rsqrtf(wave_sum(s) * (1.f / DM) + EPS);
            unsigned long long* o8 = (unsigned long long*)(MH + (size_t)m * DM) + lane;
#pragma unroll
            for (int j = 0; j < 4; ++j) { v[j] = v[j] * rstd * gv[j]; o8[64 * j] = (unsigned long long)cvtpk(v[j][0], v[j][1]) | ((unsigned long long)cvtpk(v[j][2], v[j][3]) << 32); }
        }
        __syncthreads();
    }
    SYNC_AFTER(0);

    if (IN(1)) {
        if (bx >= G - 16) {
            const int seq = (bx - (G - 16)) * 8 + wid;
            if (seq < NB * 8) {
                const f32x4* src = (const f32x4*)(LOGF + (size_t)seq * SEQ + lane * 32);
                float run = 0.f;
#pragma unroll
                for (int i = 0; i < 8; ++i) { const f32x4 v = src[i]; run += (v[0] + v[1]) + (v[2] + v[3]); }
                float incl = run;
#pragma unroll
                for (int o = 1; o < 64; o <<= 1) { const float t = __shfl_up(incl, o); if (lane >= o) incl += t; }
                float pre = incl - run;
                f32x4* dst = (f32x4*)(C2 + (size_t)seq * SEQ + lane * 32);
#pragma unroll
                for (int i = 0; i < 8; ++i) { f32x4 v = src[i]; v[0] += pre; v[1] += v[0]; v[2] += v[1]; v[3] += v[2]; pre = v[3]; dst[i] = v * LOG2E; }
            }
        }
        { pg8::Gemm g{(const char*)H, (const char*)(ws + WS_W1), 1024, 0, 0, 0}; pg8::Order S; S.init(NTOK, UPN, G, bx, 1);
          EpiProj E{(bf16_t*)(ws + WS_QK), (unsigned char*)(ws + WS_G), (const float*)(ws + WS_CTL + 4096), a.in[4]};
          pg8::gemm_phase<EpiProj>(lds, g, S, E); }
        { pg8::Gemm g{(const char*)(ws + WS_WV), (const char*)H, 1024, 0, 0, 0}; pg8::Order S; S.init(1024, NTOK, G, bx, 1);
          EpiNat E{VT, NTOK};
          pg8::gemm_phase<EpiNat>(lds, g, S, E); }
    }
    SYNC_AFTER(1);

    if (IN(2)) {
        AttnP P{(const bf16_t*)(ws + WS_QK), VT, (const bf16_t*)(ws + WS_MK), (const bf16_t*)(ws + WS_MVT), C2, (bf16_t*)(ws + WS_O), a.out,
                a.in[7], a.in[8], a.in[9], a.in[10], a.in[11], a.in[17], a.in[18], (const float*)(ws + WS_CTL + 4096)};
        LAS int* uw = (LAS int*)(lds + AT_UNITW);
        for (int j = bx; j < 64; j += G) {
            if (j < 32) { pg8::Gemm g{(const char*)MH, (const char*)(ws + WS_WMK), 1024, 0, 0, 0}; pg8::Order S; S.init(NMTOK, 512, 32, j, 1);
                EpiPlain E{(bf16_t*)(ws + WS_MK), 512};
                pg8::gemm_phase<EpiPlain>(lds, g, S, E); }
            else { pg8::Gemm g{(const char*)(ws + WS_WMV), (const char*)MH, 1024, 0, 0, 0}; pg8::Order S; S.init(512, NMTOK, 32, j - 32, 1);
                EpiNat E{(bf16_t*)(ws + WS_MVT), NMTOK};
                pg8::gemm_phase<EpiNat>(lds, g, S, E); }
            asm volatile("s_waitcnt vmcnt(0)" ::: "memory");
            __syncthreads();
            if (tid == 0) { __builtin_amdgcn_fence(__ATOMIC_RELEASE, "agent"); asm volatile("s_waitcnt vmcnt(0)" ::: "memory");
                __hip_atomic_fetch_add(CTL + 128, 1u, __ATOMIC_RELAXED, __HIP_MEMORY_SCOPE_AGENT); }
        }
        bool mem_ready = false;
        int idx = bx;
        if (wid >= 4) __builtin_amdgcn_s_setprio(1);
        for (;;) {
            if (idx >= N_ATT_UNITS) break;
            unsigned nxt = 0u;
            if (tid == 0) nxt = atomicAdd(CTL, 1u);
            int kind, qb, sub; decode_unit(idx, kind, qb, sub);
            if (kind == 0) attn_unit<0>(lds, P, sub >> 2, sub & 3, qb);
            else if (kind == 1) attn_fx64(lds, P, sub >> 3, sub & 7, qb);
            else {
                if (!mem_ready) {
                    if (tid == 0) { while (__hip_atomic_load(CTL + 128, __ATOMIC_RELAXED, __HIP_MEMORY_SCOPE_AGENT) < 64u) __builtin_amdgcn_s_sleep(8);
                        __builtin_amdgcn_fence(__ATOMIC_ACQUIRE, "agent"); asm volatile("s_waitcnt vmcnt(0)" ::: "memory"); }
                    __syncthreads();
                    mem_ready = true;
                }
                attn_unit<2>(lds, P, sub >> 2, sub & 3, qb);
            }
            if (tid == 0) *uw = G + (int)nxt;
            __syncthreads();
            idx = __builtin_amdgcn_readfirstlane(*uw);
            __syncthreads();
        }
        __builtin_amdgcn_s_setprio(0);
    }
    SYNC_AFTER(2);

    if (IN(3)) {
        pg8::Gemm g{(const char*)(ws + WS_O), (const char*)(ws + WS_WBR), 512, 0, (size_t)NTOK * 512 * 2, (size_t)1024 * 512 * 2}; pg8::Order S; S.init(NTOK, DM, G, bx, 3);
        EpiMerge E{(const unsigned char*)(ws + WS_G), (bf16_t*)(ws + WS_MERGED)};
        pg8::gemm_phase<EpiMerge>(lds, g, S, E);
    }
    SYNC_AFTER(3);

    if (IN(4)) {
        pg8::Gemm g{(const char*)(ws + WS_MERGED), (const char*)(ws + WS_WOUT), 1024, 0, 0, 0}; pg8::Order S; S.init(NTOK, DM, G, bx, 1);
        EpiOut E{x, a.out, (bf16_t*)(ws + WS_X1B), SS};
        pg8::gemm_phase<EpiOut>(lds, g, S, E);
    }
    SYNC_AFTER(4);

    if (IN(5)) {
        pg8::Gemm g{(const char*)(ws + WS_X1B), (const char*)(ws + WS_WUP), 1024, 1, 0, 0}; pg8::Order S; S.init(NTOK, UPN, G, bx, 1);
        EpiUp E{SS, a.in[25], a.in[26], (bf16_t*)(ws + WS_ACT), (float*)(ws + WS_UB)};
        pg8::gemm_phase<EpiUp>(lds, g, S, E);
    }
    SYNC_AFTER(5);

    if (IN(6)) {
        pg8::Order S; S.init(NTOK, DM, G, bx, 1);
        const float* UB = (const float*)(ws + WS_UB); bf16_t* ACT = (bf16_t*)(ws + WS_ACT);
        const float* cw = a.in[25]; const float* cb = a.in[26];
        Unit u;
        for (int i = 0; S.next(i, u); ++i) {
            for (int gg = 0; gg < 2; ++gg) {
                const int grp = u.pm * 2 + gg; const bool hasprev = (grp & 15) != 0;
                const float* ub = UB + (size_t)grp * DFF * 8; const float* pb = UB + (size_t)(grp - 1) * DFF * 8 + 4;
                for (int ch = tid; ch < DFF; ch += 512) {
                    const f32x4 uf = *(const f32x4*)(ub + (size_t)ch * 8);
                    const float u0a = uf[0], u0g = uf[1], u1a = uf[2], u1g = uf[3];
                    float p2a = 0.f, p1a = 0.f, p2g = 0.f, p1g = 0.f;
                    if (hasprev) { const f32x4 pf_ = *(const f32x4*)(pb + (size_t)ch * 8); p2a = pf_[0]; p2g = pf_[1]; p1a = pf_[2]; p1g = pf_[3]; }
                    const float wa0 = cw[ch], wa1 = cw[UPN + ch], wa2 = cw[2 * UPN + ch], ba = cb[ch];
                    const float wg0 = cw[DFF + ch], wg1 = cw[UPN + DFF + ch], wg2 = cw[2 * UPN + DFF + ch], bg = cb[DFF + ch];
                    const float ca0 = wa0 * p2a + wa1 * p1a + wa2 * u0a + ba, cg0 = wg0 * p2g + wg1 * p1g + wg2 * u0g + bg;
                    const float ca1 = wa0 * p1a + wa1 * u0a + wa2 * u1a + ba, cg1 = wg0 * p1g + wg1 * u0g + wg2 * u1g + bg;
                    const unsigned w0 = cvtpk(ca0 * sigmoidf_(ca0) * cg0, 0.f), w1 = cvtpk(ca1 * sigmoidf_(ca1) * cg1, 0.f);
                    ACT[(size_t)(grp * 128) * DFF + ch] = (bf16_t)(w0 & 0xffffu);
                    ACT[(size_t)(grp * 128 + 1) * DFF + ch] = (bf16_t)(w1 & 0xffffu);
                }
            }
        }
        asm volatile("s_waitcnt vmcnt(0)" ::: "memory");
        __syncthreads();
        pg8::Gemm g{(const char*)(ws + WS_ACT), (const char*)(ws + WS_WDN), DFF, 0, 0, 0};
        EpiDown E{a.out, (const bf16_t*)(ws + WS_X1B)};
        pg8::gemm_phase<EpiDown>(lds, g, S, E);
    }
#undef IN
#undef SYNC_AFTER
}

extern "C" void kernel_launch(void* const* d_in, const int* in_sizes, int n_in, void* d_out, int out_size, void* d_ws, size_t ws_size, hipStream_t stream) {
    static int grid = 0;
    if (grid == 0) {
        int dev = 0, cus = 0, per_cu = 0;
        if (hipGetDevice(&dev) != hipSuccess || hipDeviceGetAttribute(&cus, hipDeviceAttributeMultiprocessorCount, dev) != hipSuccess) { fprintf(stderr, "kernel_launch: device query failed\n"); grid = -1; return; }
        if (hipFuncSetAttribute((const void*)mega_fwd, hipFuncAttributeMaxDynamicSharedMemorySize, LDS_BYTES) != hipSuccess) { fprintf(stderr, "kernel_launch: hipFuncSetAttribute failed\n"); grid = -1; return; }
        if (hipOccupancyMaxActiveBlocksPerMultiprocessor(&per_cu, (const void*)mega_fwd, 512, LDS_BYTES) != hipSuccess || per_cu < 1) { fprintf(stderr, "kernel_launch: occupancy query says %d\n", per_cu); per_cu = 1; }
        (void)hipGetLastError();
        grid = cus * per_cu;
        if (n_in != 28 || ws_size < 512 * MiB) fprintf(stderr, "kernel_launch: unexpected n_in %d / ws %zu\n", n_in, ws_size);
    }
    if (grid < 0) return;
    Args a{};
    for (int i = 0; i < 28; ++i) a.in[i] = (const float*)d_in[i];
    a.out = (float*)d_out; a.ws = (unsigned char*)d_ws;
#if MK_PER_PHASE
    for (int p = 0; p < 7; ++p) { a.ph_lo = p; a.ph_hi = p + 1; hipLaunchKernelGGL(mega_fwd, dim3(grid), dim3(512), LDS_BYTES, stream, a); }
#else
    (void)hipMemsetAsync(d_ws, 0, 24576, stream);
    a.ph_lo = 0; a.ph_hi = 7;
    void* args[] = {&a};
    hipError_t e = hipLaunchCooperativeKernel((const void*)mega_fwd, dim3(grid), dim3(512), args, LDS_BYTES, stream);
    if (e != hipSuccess) fprintf(stderr, "kernel_launch: cooperative launch failed: %s (grid %d)\n", hipGetErrorString(e), grid);
#endif
}
```
